# Optimizing an MI355X kernel written in HIP

```python
import math
import jax, jax.numpy as jnp
from jax import lax
import numpy as np

D_MODEL = 4096
BATCH = 4
SEQ = 4096
DEPTH = 2

MEM_LEN = 256
MIX_W = D_MODEL
ATTN_HEAD_DIM = 128
ATTN_W = MIX_W // 2
N_ATTN_HEADS = ATTN_W // ATTN_HEAD_DIM
CONV_W = MIX_W // 4
SSM_W = MIX_W - ATTN_W - CONV_W
CONV_WIDTH = 31
SSM_GROUP_CH = 16
SSM_GROUPS = SSM_W // SSM_GROUP_CH
SSM_STATE = 64
DILATION_PATTERNS = ((128, 1), (512, 4), (2048, 16))
N_MEM_HEADS = 4
MEM_HEAD_DIM = 128
MEM_W = N_MEM_HEADS * MEM_HEAD_DIM
D_FF = 4 * D_MODEL
IN_W = 3 * ATTN_W + 2 * CONV_W + SSM_W
EPS = 1e-6
NEG_INF = -1e30

kernel_name = "hybrid_dilattn_conformer_s5_block"


def rms_norm(x, g):
    xf = x.astype(jnp.float32)
    y = xf * lax.rsqrt(jnp.mean(xf * xf, axis=-1, keepdims=True) + EPS)
    return (y * g.astype(jnp.float32)).astype(x.dtype)


def layer_norm(x, g, b):
    xf = x.astype(jnp.float32)
    mu = jnp.mean(xf, axis=-1, keepdims=True)
    xc = xf - mu
    y = xc * lax.rsqrt(jnp.mean(xc * xc, axis=-1, keepdims=True) + EPS)
    return (y * g.astype(jnp.float32) + b.astype(jnp.float32)).astype(x.dtype)


def dilated_window_attention(q, k, v, window, dilation):
    bsz, seq, heads, hd = q.shape
    blk = window // dilation
    sub_len = seq // dilation
    n_blk = -(-sub_len // blk)
    pad_len = n_blk * blk - sub_len

    def to_blocks(t):
        t = t.reshape(bsz, sub_len, dilation, heads, hd).transpose(0, 2, 3, 1, 4)
        t = jnp.pad(t, ((0, 0), (0, 0), (0, 0), (0, pad_len), (0, 0)))
        return t.reshape(bsz, dilation, heads, n_blk, blk, hd)

    def with_prev(t):
        prev = jnp.pad(t, ((0, 0), (0, 0), (0, 0), (1, 0), (0, 0), (0, 0)))[:, :, :, :-1]
        return jnp.concatenate([prev, t], axis=-2)

    qb = to_blocks(q)
    kb = with_prev(to_blocks(k))
    vb = with_prev(to_blocks(v))
    s = jnp.einsum('brhnqe,brhnke->brhnqk', qb, kb)
    qi = jnp.arange(blk)[:, None]
    kj = jnp.arange(2 * blk)[None, :]
    dist = qi + blk - kj
    bi = jnp.arange(n_blk)[:, None, None]
    valid = (dist >= 0) & (dist <= blk) & (bi * blk + kj - blk >= 0)
    s = jnp.where(valid, s, NEG_INF)
    m = jnp.max(s, axis=-1, keepdims=True)
    p = jnp.exp(s - m)
    den = jnp.sum(p, axis=-1, keepdims=True)
    o = jnp.einsum('brhnqk,brhnke->brhnqe', p, vb) / den
    lse = (m + jnp.log(den))[..., 0]
    o = o.reshape(bsz, dilation, heads, n_blk * blk, hd)[:, :, :, :sub_len]
    o = o.transpose(0, 3, 1, 2, 4).reshape(bsz, seq, heads, hd)
    lse = lse.reshape(bsz, dilation, heads, n_blk * blk)[..., :sub_len]
    lse = lse.transpose(0, 3, 1, 2).reshape(bsz, seq, heads)
    return o, lse


def dilated_mixture_attention(q, k, v, q_g, k_g):
    bsz, seq, _ = q.shape
    shp = (bsz, seq, N_ATTN_HEADS, ATTN_HEAD_DIM)
    qf = rms_norm(q.reshape(shp).astype(jnp.float32), q_g) * (ATTN_HEAD_DIM ** -0.5)
    kf = rms_norm(k.reshape(shp).astype(jnp.float32), k_g)
    vf = v.reshape(shp).astype(jnp.float32)
    outs, lses = [], []
    for window, dilation in DILATION_PATTERNS:
        o, lse = dilated_window_attention(qf, kf, vf, window, dilation)
        outs.append(o)
        lses.append(lse)
    wts = jax.nn.softmax(jnp.stack(lses, axis=0), axis=0)
    o = jnp.sum(wts[..., None] * jnp.stack(outs, axis=0), axis=0)
    return o.reshape(bsz, seq, ATTN_W).astype(q.dtype)


def conformer_conv(a, gate, dw, dw_b, ln_g, ln_b):
    h = a * jax.nn.sigmoid(gate)
    h = lax.conv_general_dilated(h, dw.astype(h.dtype), window_strides=(1,),
                                 padding=[(CONV_WIDTH - 1, 0)],
                                 dimension_numbers=('NWC', 'WIO', 'NWC'),
                                 feature_group_count=CONV_W)
    h = h + dw_b.astype(h.dtype)
    return jax.nn.silu(layer_norm(h, ln_g, ln_b))


def s5_glu(u, a_re, a_im, b_re, b_im, c_re, c_im, d_skip, log_step, w_glu, b_glu):
    bsz, seq, _ = u.shape
    f32 = jnp.float32
    uf = u.astype(f32).reshape(bsz, seq, SSM_GROUPS, SSM_GROUP_CH)
    lam = lax.complex(a_re.astype(f32), a_im.astype(f32))
    step = jnp.exp(log_step.astype(f32))[:, None]
    lam_bar = jnp.exp(lam * step)
    b = lax.complex(b_re.astype(f32), b_im.astype(f32))
    b_bar = ((lam_bar - 1.0) / lam)[..., None] * b
    bu = jnp.einsum('bsgh,gph->bsgp', uf.astype(jnp.complex64), b_bar)
    a_seq = jnp.broadcast_to(lam_bar, bu.shape)

    def combine(left, right):
        a_l, x_l = left
        a_r, x_r = right
        return a_r * a_l, a_r * x_l + x_r

    _, states = lax.associative_scan(combine, (a_seq, bu), axis=1)
    c = lax.complex(c_re.astype(f32), c_im.astype(f32))
    y = jnp.einsum('bsgp,ghp->bsgh', states, c).real
    y = y + d_skip.astype(f32).reshape(SSM_GROUPS, SSM_GROUP_CH) * uf
    z = jax.nn.gelu(y.reshape(bsz, seq, SSM_W))
    out = z * jax.nn.sigmoid(z @ w_glu.astype(f32) + b_glu.astype(f32))
    return out.astype(u.dtype)


def memory_cross_attention(h, mem_n, w_cq, w_ckv, cq_g, ck_g, w_co):
    bsz, seq, _ = h.shape
    q = (h @ w_cq).reshape(bsz, seq, N_MEM_HEADS, MEM_HEAD_DIM).astype(jnp.float32)
    kv = mem_n @ w_ckv
    k, v = jnp.split(kv, 2, axis=-1)
    mlen = mem_n.shape[1]
    k = k.reshape(bsz, mlen, N_MEM_HEADS, MEM_HEAD_DIM).astype(jnp.float32)
    v = v.reshape(bsz, mlen, N_MEM_HEADS, MEM_HEAD_DIM).astype(jnp.float32)
    q = rms_norm(q, cq_g) * (MEM_HEAD_DIM ** -0.5)
    k = rms_norm(k, ck_g)
    p = jax.nn.softmax(jnp.einsum('bshe,bmhe->bhsm', q, k), axis=-1)
    o = jnp.einsum('bhsm,bmhe->bshe', p, v).reshape(bsz, seq, MEM_W).astype(h.dtype)
    return o @ w_co


def setup_inputs(seed: int = 0) -> dict:
    key = jax.random.key(seed)
    ks = jax.random.split(key, 40)
    f32 = jnp.float32

    def nrm(k, shape, scale):
        return jax.random.normal(k, shape, f32) * scale

    def gain(k, shape):
        return 1.0 + 0.01 * jax.random.normal(k, shape, f32)

    L = DEPTH
    a_im = jnp.pi * jnp.broadcast_to(jnp.arange(SSM_STATE, dtype=f32), (L, SSM_GROUPS, SSM_STATE))
    return {
        "x": jax.random.normal(ks[0], (BATCH, SEQ, D_MODEL), f32),
        "mem": jax.random.normal(ks[1], (BATCH, MEM_LEN, D_MODEL), f32),
        "norm_mix": gain(ks[2], (L, D_MODEL)),
        "w_in": nrm(ks[3], (L, D_MODEL, IN_W), D_MODEL ** -0.5),
        "q_norm": gain(ks[4], (L, ATTN_HEAD_DIM)),
        "k_norm": gain(ks[5], (L, ATTN_HEAD_DIM)),
        "conv_dw": nrm(ks[6], (L, CONV_WIDTH, 1, CONV_W), CONV_WIDTH ** -0.5),
        "conv_b": nrm(ks[7], (L, CONV_W), 0.01),
        "conv_ln_g": gain(ks[8], (L, CONV_W)),
        "conv_ln_b": nrm(ks[9], (L, CONV_W), 0.01),
        "ssm_a_re": -0.5 + nrm(ks[10], (L, SSM_GROUPS, SSM_STATE), 0.01),
        "ssm_a_im": a_im + nrm(ks[11], (L, SSM_GROUPS, SSM_STATE), 0.01),
        "ssm_b_re": nrm(ks[12], (L, SSM_GROUPS, SSM_STATE, SSM_GROUP_CH), (2 * SSM_GROUP_CH) ** -0.5),
        "ssm_b_im": nrm(ks[13], (L, SSM_GROUPS, SSM_STATE, SSM_GROUP_CH), (2 * SSM_GROUP_CH) ** -0.5),
        "ssm_c_re": nrm(ks[14], (L, SSM_GROUPS, SSM_GROUP_CH, SSM_STATE), (2 * SSM_STATE) ** -0.5),
        "ssm_c_im": nrm(ks[15], (L, SSM_GROUPS, SSM_GROUP_CH, SSM_STATE), (2 * SSM_STATE) ** -0.5),
        "ssm_d": nrm(ks[16], (L, SSM_W), 1.0),
        "ssm_log_step": jax.random.uniform(ks[17], (L, SSM_GROUPS), f32,
                                           minval=math.log(1e-3), maxval=math.log(1e-1)),
        "ssm_w_glu": nrm(ks[18], (L, SSM_W, SSM_W), SSM_W ** -0.5),
        "ssm_b_glu": nrm(ks[19], (L, SSM_W), 0.01),
        "mix_out_norm": gain(ks[20], (L, MIX_W)),
        "w_out": nrm(ks[21], (L, MIX_W, D_MODEL), MIX_W ** -0.5),
        "norm_cross": gain(ks[22], (L, D_MODEL)),
        "norm_mem": gain(ks[23], (L, D_MODEL)),
        "w_cq": nrm(ks[24], (L, D_MODEL, MEM_W), D_MODEL ** -0.5),
        "w_ckv": nrm(ks[25], (L, D_MODEL, 2 * MEM_W), D_MODEL ** -0.5),
        "cq_norm": gain(ks[26], (L, MEM_HEAD_DIM)),
        "ck_norm": gain(ks[27], (L, MEM_HEAD_DIM)),
        "w_co": nrm(ks[28], (L, MEM_W, D_MODEL), MEM_W ** -0.5),
        "norm_mlp": gain(ks[29], (L, D_MODEL)),
        "w_up": nrm(ks[30], (L, D_MODEL, D_FF), D_MODEL ** -0.5),
        "w_down": nrm(ks[31], (L, D_FF, D_MODEL), D_FF ** -0.5),
    }


def reference(x, mem, norm_mix, w_in, q_norm, k_norm, conv_dw, conv_b, conv_ln_g, conv_ln_b,
              ssm_a_re, ssm_a_im, ssm_b_re, ssm_b_im, ssm_c_re, ssm_c_im, ssm_d, ssm_log_step,
              ssm_w_glu, ssm_b_glu, mix_out_norm, w_out, norm_cross, norm_mem, w_cq, w_ckv,
              cq_norm, ck_norm, w_co, norm_mlp, w_up, w_down):
    split_at = [ATTN_W, 2 * ATTN_W, 3 * ATTN_W, 3 * ATTN_W + CONV_W, 3 * ATTN_W + 2 * CONV_W]
    for l in range(DEPTH):
        h = rms_norm(x, norm_mix[l])
        proj = h @ w_in[l]
        q, k, v, conv_a, conv_g, ssm_u = jnp.split(proj, split_at, axis=-1)
        attn = dilated_mixture_attention(q, k, v, q_norm[l], k_norm[l])
        conv = conformer_conv(conv_a, conv_g, conv_dw[l], conv_b[l], conv_ln_g[l], conv_ln_b[l])
        ssm = s5_glu(ssm_u, ssm_a_re[l], ssm_a_im[l], ssm_b_re[l], ssm_b_im[l], ssm_c_re[l],
                     ssm_c_im[l], ssm_d[l], ssm_log_step[l], ssm_w_glu[l], ssm_b_glu[l])
        g = mix_out_norm[l]
        mixed = jnp.concatenate([
            rms_norm(attn, g[:ATTN_W]),
            rms_norm(conv, g[ATTN_W:ATTN_W + CONV_W]),
            rms_norm(ssm, g[ATTN_W + CONV_W:]),
        ], axis=-1)
        x = x + mixed @ w_out[l]
        x = x + memory_cross_attention(rms_norm(x, norm_cross[l]), rms_norm(mem, norm_mem[l]),
                                       w_cq[l], w_ckv[l], cq_norm[l], ck_norm[l], w_co[l])
        h = rms_norm(x, norm_mlp[l])
        x = x + jnp.square(jax.nn.relu(h @ w_up[l])) @ w_down[l]
    return x
```

```cpp
#include <hip/hip_runtime.h>
#include <cstdio>
#include <cstdint>
#ifndef MK_ONE_LAUNCH
#define MK_ONE_LAUNCH 1
#endif
#ifndef PROBE_MASK
#define PROBE_MASK 0
#endif
#ifndef PROBE_ZERO_WS
#define PROBE_ZERO_WS 0
#endif
#ifndef USE_SSM_MFMA
#define USE_SSM_MFMA 1
#endif
#ifndef ATT_PREFETCH
#define ATT_PREFETCH 2
#endif
#ifndef USE_SWZ
#define USE_SWZ 0
#endif
#ifndef ATT_DEFER_MAX
#define ATT_DEFER_MAX 0
#endif
#ifndef ATT_GRAM
#define ATT_GRAM 1
#endif
#ifndef ATT_LSUM_LATE
#define ATT_LSUM_LATE 1
#endif
#ifndef ATT_XCD_ORDER
#define ATT_XCD_ORDER 1
#endif
#ifndef RES_BF16
#define RES_BF16 0
#endif
#ifndef RES_PINGPONG
#define RES_PINGPONG 0
#endif
#ifndef CONV_PIPE
#define CONV_PIPE 1
#endif
#if CONV_PIPE
#define CONV_ITEM conv_item4p
#else
#define CONV_ITEM conv_item4w
#endif
#ifndef ATT_EARLY_PF
#define ATT_EARLY_PF 1
#endif
#ifndef P0_PAIR
#define P0_PAIR 0
#endif
#ifndef EPI_ST_SC1
#define EPI_ST_SC1 0
#endif
#ifndef POST_PAIR
#define POST_PAIR 1
#endif
#ifndef REDUCE8
#define REDUCE8 1
#endif
namespace pg8 {
#define PG8_LAS __attribute__((address_space(3)))
typedef unsigned short bf16_t;
typedef short bf16x8 __attribute__((ext_vector_type(8)));
typedef float f32x4 __attribute__((ext_vector_type(4)));
typedef unsigned u32x4 __attribute__((ext_vector_type(4)));
constexpr int BM = 256, BK = 64, HALF = 128, HTB = HALF * BK * 2  , STAGE_BYTES = 8 * HTB, NXCD = 8, WGM = 8;

__host__ __device__ __forceinline__ int lds_byte(int r, int c) { const int st = (r >> 4) * 2 + (c >> 5), rr = r & 15, cc = c & 31, ob = rr * 64 + cc * 2; return st * 1024 + (ob ^ (((ob >> 9) & 1) << 5)); }
__host__ __device__ __forceinline__ void stage_rc(int b, int& R, int& C) { const int st = b / 1024, sb = b % 1024, swz = sb ^ (((sb >> 9) & 1) << 5); R = (st >> 1) * 16 + swz / 64; C = (st & 1) * 32 + (swz % 64) / 2; }
__host__ __device__ __forceinline__ int perm32(int rho) { const int n = rho >> 4, i = rho & 15; return 8 * (i >> 2) + 4 * n + (i & 3); }

struct Unit { int pm, pn; };
struct Gemm { const bf16_t* A; const bf16_t* Bt; int M, N, K; };

struct StaticOrder {
    int nM, nN, nwg, G, c;
    __host__ __device__ void init(int M, int N, int G_, int c_) { nM = M / BM; nN = N / BM; nwg = nM * nN; G = G_; c = c_; }
    __host__ __device__ bool next(int i, Unit& u) const {
        const long L = (long)i * G + c; if (L >= nwg) return false;
        int wgid = (int)L; { const int q = nwg / NXCD, r = nwg % NXCD, xcd = wgid % NXCD, off = wgid / NXCD; wgid = (xcd < r ? xcd * (q + 1) : r * (q + 1) + (xcd - r) * q) + off; }
        const int nig = WGM * nN, gid = wgid / nig, fm = gid * WGM, gsz = (nM - fm) < WGM ? (nM - fm) : WGM;
        u.pm = fm + ((wgid % nig) % gsz); u.pn = (wgid % nig) / gsz; return true;
    }
    __device__ __forceinline__ void a_ready(const Unit&) const {}
    __device__ __forceinline__ void done(const Unit&) const {}
};

__device__ __forceinline__ unsigned cvt_pk_bf16(float lo, float hi) { unsigned r; asm volatile("v_cvt_pk_bf16_f32 %0, %1, %2" : "=v"(r) : "v"(lo), "v"(hi)); return r; }
typedef float f32x2 __attribute__((ext_vector_type(2)));
#define PG8_GAS __attribute__((address_space(1)))
#if EPI_ST_SC1
__device__ __forceinline__ void pg8_st16_wt(PG8_GAS void* p, u32x4 v) { asm volatile("global_store_dwordx4 %0, %1, off sc1" :: "v"(p), "v"(v) : "memory"); }
#define PG8_ST16(ptr, val) pg8_st16_wt((PG8_GAS void*)(ptr), (val))
#else
#define PG8_ST16(ptr, val) (*(PG8_GAS u32x4*)(ptr) = (val))
#endif
__device__ __forceinline__ float bf_lo(unsigned w) { return __uint_as_float(w << 16); }
__device__ __forceinline__ float bf_hi(unsigned w) { return __uint_as_float(w & 0xffff0000u); }
__device__ __forceinline__ float sigmoid_f(float x) { return __builtin_amdgcn_rcpf(1.0f + __expf(-x)); }

template <int ACT> struct EpiBf16 {
    static constexpr bool PERM = true, AFTER_DRAIN = false;
    bf16_t* O; int ldc; int split_cols; size_t split_stride; const float* rs;
    __device__ __forceinline__ void operator()(const f32x4 (&acc)[2][2][4][2], const Unit& u, int wr, int wc, int fr, int fq) const {
        const int row0 = u.pm * BM + wr * 64 + fr; int colt = u.pn * BM; bf16_t* base = O;
        if (split_cols) { const int t = colt / split_cols; base += (size_t)t * split_stride; colt -= t * split_cols; }
        const int col0 = colt + wc * 32 + 8 * fq;
        float scv[2][4];
#pragma unroll
        for (int ai = 0; ai < 2; ++ai)
#pragma unroll
            for (int m = 0; m < 4; ++m) scv[ai][m] = rs ? ((const PG8_GAS float*)rs)[row0 + ai * HALF + m * 16] : 1.f;
#pragma unroll
        for (int ai = 0; ai < 2; ++ai)
#pragma unroll
            for (int m = 0; m < 4; ++m) { bf16_t* rowp = base + (size_t)(row0 + ai * HALF + m * 16) * ldc + col0;
                const float sc = scv[ai][m];
#pragma unroll
                for (int bj = 0; bj < 2; ++bj) { f32x4 v0 = acc[ai][bj][m][0] * sc, v1 = acc[ai][bj][m][1] * sc;
                    if (ACT == 3) {
#pragma unroll
                        for (int j = 0; j < 4; ++j) { const float a = fmaxf(v0[j], 0.f), b = fmaxf(v1[j], 0.f); v0[j] = a * a; v1[j] = b * b; } }
                    u32x4 w; w.x = cvt_pk_bf16(v0[0], v0[1]); w.y = cvt_pk_bf16(v0[2], v0[3]); w.z = cvt_pk_bf16(v1[0], v1[1]); w.w = cvt_pk_bf16(v1[2], v1[3]);
                    PG8_ST16(rowp + bj * HALF, w); } }
    }
};
struct EpiGlu {
    static constexpr bool PERM = true, AFTER_DRAIN = false;
    bf16_t* O; const bf16_t* Z; int ldc; const float* bias;
    __device__ __forceinline__ void operator()(const f32x4 (&acc)[2][2][4][2], const Unit& u, int wr, int wc, int fr, int fq) const {
        const int row0 = u.pm * BM + wr * 64 + fr; const int col0 = u.pn * BM + wc * 32 + 8 * fq;
        f32x4 bv[2][2];
#pragma unroll
        for (int bj = 0; bj < 2; ++bj)
#pragma unroll
            for (int n = 0; n < 2; ++n) bv[bj][n] = *(const PG8_GAS f32x4*)(bias + col0 + bj * HALF + 4 * n);
#pragma unroll
        for (int ai = 0; ai < 2; ++ai) {
            u32x4 zr[4][2];
#pragma unroll
            for (int m = 0; m < 4; ++m) { const PG8_GAS bf16_t* p = (const PG8_GAS bf16_t*)Z + (size_t)(row0 + ai * HALF + m * 16) * ldc + col0;
                asm volatile("global_load_dwordx4 %0, %2, off\n\tglobal_load_dwordx4 %1, %2, off offset:256" : "=&v"(zr[m][0]), "=&v"(zr[m][1]) : "v"(p) : "memory"); }
            asm volatile("s_waitcnt vmcnt(0)" : "+v"(zr[0][0]), "+v"(zr[0][1]), "+v"(zr[1][0]), "+v"(zr[1][1]), "+v"(zr[2][0]), "+v"(zr[2][1]), "+v"(zr[3][0]), "+v"(zr[3][1]) :: "memory");
#pragma unroll
            for (int m = 0; m < 4; ++m) { const size_t ro = (size_t)(row0 + ai * HALF + m * 16) * ldc + col0;
#pragma unroll
                for (int bj = 0; bj < 2; ++bj) { const f32x4 g0 = acc[ai][bj][m][0] + bv[bj][0], g1 = acc[ai][bj][m][1] + bv[bj][1];
                    const u32x4 zz = zr[m][bj];
                    const float o0 = bf_lo(zz.x) * sigmoid_f(g0[0]), o1 = bf_hi(zz.x) * sigmoid_f(g0[1]), o2 = bf_lo(zz.y) * sigmoid_f(g0[2]), o3 = bf_hi(zz.y) * sigmoid_f(g0[3]);
                    const float o4 = bf_lo(zz.z) * sigmoid_f(g1[0]), o5 = bf_hi(zz.z) * sigmoid_f(g1[1]), o6 = bf_lo(zz.w) * sigmoid_f(g1[2]), o7 = bf_hi(zz.w) * sigmoid_f(g1[3]);
                    u32x4 w; w.x = cvt_pk_bf16(o0, o1); w.y = cvt_pk_bf16(o2, o3); w.z = cvt_pk_bf16(o4, o5); w.w = cvt_pk_bf16(o6, o7);
                    PG8_ST16(O + ro + bj * HALF, w); } }
            asm volatile("" ::: "memory"); }
    }
};
struct EpiRes {
    static constexpr bool PERM = true, AFTER_DRAIN = false;
    const float* R; float* C; int ldc; bf16_t* XB; float* PS; int Mrows;
    __device__ __forceinline__ void operator()(const f32x4 (&acc)[2][2][4][2], const Unit& u, int wr, int wc, int fr, int fq) const {
        const int row0 = u.pm * BM + wr * 64 + fr, col0 = u.pn * BM + wc * 32 + 8 * fq; const int lane = fq * 16 + fr;
        f32x4 ra[4], rb[4];
        { const size_t off = (size_t)row0 * ldc + col0;
#pragma unroll
          for (int bj = 0; bj < 2; ++bj) { ra[2 * bj] = *(const PG8_GAS f32x4*)(R + off + bj * HALF); ra[2 * bj + 1] = *(const PG8_GAS f32x4*)(R + off + bj * HALF + 4); } }
#pragma unroll
        for (int g = 0; g < 8; ++g) { const int ai = g >> 2, m = g & 3; const size_t off = (size_t)(row0 + ai * HALF + m * 16) * ldc + col0; float s = 0.f;
            if (g < 7) { const int ai2 = (g + 1) >> 2, m2 = (g + 1) & 3; const size_t off2 = (size_t)(row0 + ai2 * HALF + m2 * 16) * ldc + col0;
#pragma unroll
                for (int bj = 0; bj < 2; ++bj) { rb[2 * bj] = *(const PG8_GAS f32x4*)(R + off2 + bj * HALF); rb[2 * bj + 1] = *(const PG8_GAS f32x4*)(R + off2 + bj * HALF + 4); } }
#pragma unroll
            for (int bj = 0; bj < 2; ++bj) {
                const f32x4 v0 = ra[2 * bj] + acc[ai][bj][m][0], v1 = ra[2 * bj + 1] + acc[ai][bj][m][1];
                *(PG8_GAS f32x4*)(C + off + bj * HALF) = v0; *(PG8_GAS f32x4*)(C + off + bj * HALF + 4) = v1;
                if (XB) { s += ((v0[0] * v0[0] + v0[1] * v0[1]) + (v0[2] * v0[2] + v0[3] * v0[3])) + ((v1[0] * v1[0] + v1[1] * v1[1]) + (v1[2] * v1[2] + v1[3] * v1[3]));
                    u32x4 w; w.x = cvt_pk_bf16(v0[0], v0[1]); w.y = cvt_pk_bf16(v0[2], v0[3]); w.z = cvt_pk_bf16(v1[0], v1[1]); w.w = cvt_pk_bf16(v1[2], v1[3]);
                    *(PG8_GAS u32x4*)(XB + off + bj * HALF) = w; } }
            if (XB) { s += __builtin_bit_cast(float, __builtin_amdgcn_ds_bpermute((lane ^ 16) << 2, __builtin_bit_cast(int, s))); s += __builtin_bit_cast(float, __builtin_amdgcn_ds_bpermute((lane ^ 32) << 2, __builtin_bit_cast(int, s)));
                if (fq == 0) ((PG8_GAS float*)PS)[(size_t)(u.pn * 4 + wc) * Mrows + row0 + ai * HALF + m * 16] = s; }
#pragma unroll
            for (int q = 0; q < 4; ++q) ra[q] = rb[q];
            asm volatile("" ::: "memory"); }
    }
};

struct EpiResB {
    static constexpr bool PERM = true, AFTER_DRAIN = false;
    const bf16_t* R; float* C; int ldc; bf16_t* XB; float* PS; int Mrows;
    __device__ __forceinline__ void operator()(const f32x4 (&acc)[2][2][4][2], const Unit& u, int wr, int wc, int fr, int fq) const {
        const int row0 = u.pm * BM + wr * 64 + fr, col0 = u.pn * BM + wc * 32 + 8 * fq; const int lane = fq * 16 + fr;
#pragma unroll
        for (int ai = 0; ai < 2; ++ai) {
            u32x4 r[4][2];
#pragma unroll
            for (int m = 0; m < 4; ++m) { const PG8_GAS bf16_t* p = (const PG8_GAS bf16_t*)R + (size_t)(row0 + ai * HALF + m * 16) * ldc + col0;
                asm volatile("global_load_dwordx4 %0, %2, off\n\tglobal_load_dwordx4 %1, %2, off offset:256" : "=&v"(r[m][0]), "=&v"(r[m][1]) : "v"(p) : "memory"); }
            asm volatile("s_waitcnt vmcnt(0)" : "+v"(r[0][0]), "+v"(r[0][1]), "+v"(r[1][0]), "+v"(r[1][1]), "+v"(r[2][0]), "+v"(r[2][1]), "+v"(r[3][0]), "+v"(r[3][1]) :: "memory");
#pragma unroll
            for (int m = 0; m < 4; ++m) { const size_t off = (size_t)(row0 + ai * HALF + m * 16) * ldc + col0; float s = 0.f;
#pragma unroll
                for (int bj = 0; bj < 2; ++bj) { const u32x4 rr = r[m][bj];
                    f32x4 v0, v1;
                    v0[0] = __builtin_bit_cast(float, rr.x << 16); v0[1] = __builtin_bit_cast(float, rr.x & 0xffff0000u); v0[2] = __builtin_bit_cast(float, rr.y << 16); v0[3] = __builtin_bit_cast(float, rr.y & 0xffff0000u);
                    v1[0] = __builtin_bit_cast(float, rr.z << 16); v1[1] = __builtin_bit_cast(float, rr.z & 0xffff0000u); v1[2] = __builtin_bit_cast(float, rr.w << 16); v1[3] = __builtin_bit_cast(float, rr.w & 0xffff0000u);
                    v0 += acc[ai][bj][m][0]; v1 += acc[ai][bj][m][1];
                    if (C) { PG8_ST16(C + off + bj * HALF, __builtin_bit_cast(u32x4, v0)); PG8_ST16(C + off + bj * HALF + 4, __builtin_bit_cast(u32x4, v1)); }
                    if (XB) { s += ((v0[0] * v0[0] + v0[1] * v0[1]) + (v0[2] * v0[2] + v0[3] * v0[3])) + ((v1[0] * v1[0] + v1[1] * v1[1]) + (v1[2] * v1[2] + v1[3] * v1[3]));
                        u32x4 w; w.x = cvt_pk_bf16(v0[0], v0[1]); w.y = cvt_pk_bf16(v0[2], v0[3]); w.z = cvt_pk_bf16(v1[0], v1[1]); w.w = cvt_pk_bf16(v1[2], v1[3]);
                        PG8_ST16(XB + off + bj * HALF, w); } }
                if (XB) { s += __builtin_bit_cast(float, __builtin_amdgcn_ds_bpermute((lane ^ 16) << 2, __builtin_bit_cast(int, s))); s += __builtin_bit_cast(float, __builtin_amdgcn_ds_bpermute((lane ^ 32) << 2, __builtin_bit_cast(int, s)));
                    if (fq == 0) ((PG8_GAS float*)PS)[(size_t)(u.pn * 4 + wc) * Mrows + row0 + ai * HALF + m * 16] = s; } }
            asm volatile("" ::: "memory"); }
    }
};

struct EpiInproj {
    static constexpr bool PERM = true, AFTER_DRAIN = false;
    bf16_t* O; const float* rs;
    __device__ __forceinline__ void operator()(const f32x4 (&acc)[2][2][4][2], const Unit& u, int wr, int wc, int fr, int fq) const {
        const int row0 = u.pm * BM + wr * 64 + fr; const size_t TS = (size_t)16384 * 1024;
        float scv[2][4];
#pragma unroll
        for (int ai = 0; ai < 2; ++ai)
#pragma unroll
            for (int m = 0; m < 4; ++m) scv[ai][m] = ((const PG8_GAS float*)rs)[row0 + ai * HALF + m * 16];
        if (u.pn >= 24 && u.pn < 32) {
            bf16_t* base = O + 6 * TS + 128 * (u.pn - 24) + wc * 32 + 8 * fq;
#pragma unroll
            for (int ai = 0; ai < 2; ++ai)
#pragma unroll
                for (int m = 0; m < 4; ++m) { const float sc = scv[ai][m];
                    const f32x4 a0 = acc[ai][0][m][0] * sc, a1 = acc[ai][0][m][1] * sc, g0 = acc[ai][1][m][0] * sc, g1 = acc[ai][1][m][1] * sc;
                    u32x4 w; w.x = cvt_pk_bf16(a0[0] * sigmoid_f(g0[0]), a0[1] * sigmoid_f(g0[1])); w.y = cvt_pk_bf16(a0[2] * sigmoid_f(g0[2]), a0[3] * sigmoid_f(g0[3]));
                    w.z = cvt_pk_bf16(a1[0] * sigmoid_f(g1[0]), a1[1] * sigmoid_f(g1[1])); w.w = cvt_pk_bf16(a1[2] * sigmoid_f(g1[2]), a1[3] * sigmoid_f(g1[3]));
                    PG8_ST16(base + (size_t)(row0 + ai * HALF + m * 16) * 1024, w); }
        } else {
            const int colt = u.pn * BM; const int t = u.pn >= 32 ? 8 : colt >> 10; const int cin = u.pn >= 32 ? colt - 8192 : colt & 1023;
            bf16_t* base = O + (size_t)t * TS + cin + wc * 32 + 8 * fq;
#pragma unroll
            for (int ai = 0; ai < 2; ++ai)
#pragma unroll
                for (int m = 0; m < 4; ++m) { bf16_t* rowp = base + (size_t)(row0 + ai * HALF + m * 16) * 1024; const float sc = scv[ai][m];
#pragma unroll
                    for (int bj = 0; bj < 2; ++bj) { const f32x4 v0 = acc[ai][bj][m][0] * sc, v1 = acc[ai][bj][m][1] * sc;
                        u32x4 w; w.x = cvt_pk_bf16(v0[0], v0[1]); w.y = cvt_pk_bf16(v0[2], v0[3]); w.z = cvt_pk_bf16(v1[0], v1[1]); w.w = cvt_pk_bf16(v1[2], v1[3]);
                        PG8_ST16(rowp + bj * HALF, w); } }
        }
    }
};

template <class Epi, class Sched, bool ALIGN_EPI = false, bool SP2 = false>
__device__ __forceinline__ void gemm_phase(PG8_LAS unsigned char* lds, const Gemm g, const Sched& S, const Epi& E, int wv  ) {
    int lane_ = (int)__builtin_amdgcn_mbcnt_hi(~0u, __builtin_amdgcn_mbcnt_lo(~0u, 0u)); asm volatile("" : "+v"(lane_));
    const int wid = wv, lane = lane_, tid = wid * 64 + lane, wr = wid >> 2, wc = wid & 3, fr = lane & 15, fq = lane >> 4;
    const int K = g.K, nt = K / BK;
    unsigned voffA[2], voffB[2];
#pragma unroll
    for (int i = 0; i < 2; ++i) { int R, C; stage_rc(tid * 16 + i * 8192, R, C); const int Rb = Epi::PERM ? ((R & ~31) + perm32(R & 31)) : R;
        voffA[i] = (unsigned)(R * K + C) * 2u; voffB[i] = (unsigned)(Rb * K + C) * 2u; }
    const size_t kstep = (size_t)(BK * 2);
    const size_t hstep = (size_t)HALF * K * 2;
    const size_t tstep = 2 * hstep;
    const unsigned ldsw = (unsigned)wid * 1024u;
    const int aoff = lds_byte(wr * 64 + fr, fq * 8), boff = lds_byte(wc * 32 + fr, fq * 8);
#define PG8_SA(b, h) (((b) * 2 + (h)) * HTB)
#define PG8_SB(b, h) ((4 + (b) * 2 + (h)) * HTB)
#define PG8_STAGE(bufoff, gbase, voff) do { _Pragma("unroll") for (int _i = 0; _i < 2; ++_i) \
        __builtin_amdgcn_global_load_lds((const unsigned*)((const char*)(gbase) + (voff)[_i]), (PG8_LAS unsigned*)(lds + (bufoff) + ldsw + _i * 8192), 16, 0, 0); } while (0)
#define PG8_LDA(dst, b, h) do { _Pragma("unroll") for (int m = 0; m < 4; ++m) _Pragma("unroll") for (int k = 0; k < 2; ++k) dst[m][k] = *(const PG8_LAS bf16x8*)(lds + PG8_SA(b, h) + aoff + m * 2048 + k * 1024); } while (0)
#define PG8_LDB(dst, b, h) do { _Pragma("unroll") for (int n = 0; n < 2; ++n) _Pragma("unroll") for (int k = 0; k < 2; ++k) dst[n][k] = *(const PG8_LAS bf16x8*)(lds + PG8_SB(b, h) + boff + n * 2048 + k * 1024); } while (0)
#define PG8_MMA(ai, bj, At, Bt) do { __builtin_amdgcn_s_setprio(1); _Pragma("unroll") for (int m = 0; m < 4; ++m) _Pragma("unroll") for (int n = 0; n < 2; ++n) _Pragma("unroll") for (int k = 0; k < 2; ++k) \
        acc[ai][bj][m][n] = __builtin_amdgcn_mfma_f32_16x16x32_bf16(Bt[n][k], At[m][k], acc[ai][bj][m][n], 0, 0, 0); __builtin_amdgcn_s_setprio(0); } while (0)
#define PG8_WAIT_V(n) asm volatile("s_waitcnt vmcnt(" #n ")" ::: "memory")
#define PG8_WAIT_L(n) asm volatile("s_waitcnt lgkmcnt(" #n ")" ::: "memory")
#define PG8_BAR __builtin_amdgcn_s_barrier()
#define PG8_SCHED __builtin_amdgcn_sched_barrier(0)
    Unit cur, nxt; int ui = 0;
    if (!S.next(0, cur)) return;
    f32x4 acc[2][2][4][2];
#pragma unroll
    for (int a = 0; a < 2; ++a)
#pragma unroll
        for (int b = 0; b < 2; ++b)
#pragma unroll
            for (int m = 0; m < 4; ++m)
#pragma unroll
                for (int n = 0; n < 2; ++n) acc[a][b][m][n] = (f32x4){0.f, 0.f, 0.f, 0.f};
    bf16x8 At[4][2], B0[2][2], B1[2][2];
    const char* cA = (const char*)g.A + (size_t)cur.pm * tstep; const char* cB = (const char*)g.Bt + (size_t)cur.pn * tstep;
    S.a_ready(cur);
    if constexpr (SP2) {
        PG8_STAGE(PG8_SB(0, 0), cB, voffB); PG8_STAGE(PG8_SB(0, 1), cB + hstep, voffB); PG8_STAGE(PG8_SA(0, 0), cA, voffA); PG8_STAGE(PG8_SA(0, 1), cA + hstep, voffA);
        if (wr == 1) PG8_BAR;
        PG8_WAIT_V(2); PG8_BAR;
        PG8_STAGE(PG8_SB(1, 0), cB + kstep, voffB); PG8_STAGE(PG8_SA(1, 0), cA + kstep, voffA); PG8_STAGE(PG8_SB(1, 1), cB + hstep + kstep, voffB);
        PG8_WAIT_V(6); PG8_BAR;
    } else {
        PG8_STAGE(PG8_SB(0, 0), cB, voffB); PG8_STAGE(PG8_SA(0, 0), cA, voffA); PG8_STAGE(PG8_SB(0, 1), cB + hstep, voffB); PG8_STAGE(PG8_SA(0, 1), cA + hstep, voffA);
        if (wr == 1) PG8_BAR;
        PG8_WAIT_V(4); PG8_BAR;
        PG8_STAGE(PG8_SB(1, 0), cB + kstep, voffB); PG8_STAGE(PG8_SA(1, 0), cA + kstep, voffA); PG8_STAGE(PG8_SB(1, 1), cB + hstep + kstep, voffB);
        PG8_WAIT_V(6); PG8_BAR;
    }
    for (;;) {
        const bool has_next = S.next(ui + 1, nxt);
        const char* nA = has_next ? (const char*)g.A + (size_t)nxt.pm * tstep : cA; const char* nB = has_next ? (const char*)g.Bt + (size_t)nxt.pn * tstep : cB;
        for (int t = 0; t < nt; t += 2) {
            const bool last = (t == nt - 2);
            const char* a1 = cA + (size_t)(t + 1) * kstep;
            const char* a2 = last ? nA : cA + (size_t)(t + 2) * kstep; const char* b2 = last ? nB : cB + (size_t)(t + 2) * kstep;
            const char* a3 = a2 + kstep; const char* b3 = b2 + kstep;
            if (last && has_next) S.a_ready(nxt);
            if constexpr (SP2) {
            PG8_LDB(B0, 0, 0); PG8_LDB(B1, 0, 1); PG8_SCHED; PG8_LDA(At, 0, 0); PG8_STAGE(PG8_SA(1, 1), a1 + hstep, voffA);
            PG8_WAIT_V(8); PG8_WAIT_L(0); PG8_BAR; PG8_MMA(0, 0, At, B0); PG8_MMA(0, 1, At, B1); PG8_BAR; PG8_SCHED;
            PG8_LDA(At, 0, 1); PG8_STAGE(PG8_SB(0, 0), b2, voffB); PG8_STAGE(PG8_SB(0, 1), b2 + hstep, voffB); PG8_STAGE(PG8_SA(0, 0), a2, voffA);
            PG8_WAIT_V(8); PG8_WAIT_L(0); PG8_BAR; PG8_MMA(1, 0, At, B0); PG8_MMA(1, 1, At, B1); PG8_BAR; PG8_SCHED;
            PG8_LDB(B0, 1, 0); PG8_LDB(B1, 1, 1); PG8_SCHED; PG8_LDA(At, 1, 0); PG8_STAGE(PG8_SA(0, 1), a2 + hstep, voffA);
            PG8_WAIT_V(8); PG8_WAIT_L(0); PG8_BAR; PG8_MMA(0, 0, At, B0); PG8_MMA(0, 1, At, B1); PG8_BAR; PG8_SCHED;
            PG8_LDA(At, 1, 1); PG8_STAGE(PG8_SB(1, 0), b3, voffB); PG8_STAGE(PG8_SB(1, 1), b3 + hstep, voffB); PG8_STAGE(PG8_SA(1, 0), a3, voffA);
            PG8_WAIT_V(8); PG8_WAIT_L(0); PG8_BAR; PG8_MMA(1, 0, At, B0); PG8_MMA(1, 1, At, B1); PG8_BAR; PG8_SCHED;
            } else {
            PG8_LDB(B0, 0, 0); PG8_SCHED; PG8_LDA(At, 0, 0); PG8_STAGE(PG8_SA(1, 1), a1 + hstep, voffA);
            PG8_WAIT_L(8); PG8_BAR; PG8_WAIT_L(0); PG8_MMA(0, 0, At, B0); PG8_BAR; PG8_SCHED;
            PG8_LDB(B1, 0, 1); PG8_STAGE(PG8_SB(0, 0), b2, voffB);
            PG8_BAR; PG8_WAIT_L(0); PG8_MMA(0, 1, At, B1); PG8_BAR;
            PG8_LDA(At, 0, 1); PG8_STAGE(PG8_SA(0, 0), a2, voffA);
            PG8_BAR; PG8_WAIT_L(0); PG8_MMA(1, 0, At, B0); PG8_BAR; PG8_SCHED;
            PG8_STAGE(PG8_SB(0, 1), b2 + hstep, voffB);
            PG8_WAIT_V(6); PG8_BAR; PG8_MMA(1, 1, At, B1); PG8_BAR;
            PG8_LDB(B0, 1, 0); PG8_SCHED; PG8_LDA(At, 1, 0); PG8_STAGE(PG8_SA(0, 1), a2 + hstep, voffA);
            PG8_WAIT_L(8); PG8_BAR; PG8_WAIT_L(0); PG8_MMA(0, 0, At, B0); PG8_BAR; PG8_SCHED;
            PG8_LDB(B1, 1, 1); PG8_STAGE(PG8_SB(1, 0), b3, voffB);
            PG8_BAR; PG8_WAIT_L(0); PG8_MMA(0, 1, At, B1); PG8_BAR;
            PG8_LDA(At, 1, 1); PG8_STAGE(PG8_SA(1, 0), a3, voffA);
            PG8_BAR; PG8_WAIT_L(0); PG8_MMA(1, 0, At, B0); PG8_BAR; PG8_SCHED;
            PG8_STAGE(PG8_SB(1, 1), b3 + hstep, voffB);
            PG8_WAIT_V(6); PG8_BAR; PG8_MMA(1, 1, At, B1); PG8_BAR;
            }
        }
        if constexpr (ALIGN_EPI) { if (wr == 0) PG8_BAR; }
        if constexpr (!Epi::AFTER_DRAIN) { E(acc, cur, wr, wc, fr, fq); S.done(cur); }
        if (!has_next) break;
#pragma unroll
        for (int a = 0; a < 2; ++a)
#pragma unroll
            for (int b = 0; b < 2; ++b)
#pragma unroll
                for (int m = 0; m < 4; ++m)
#pragma unroll
                    for (int n = 0; n < 2; ++n) acc[a][b][m][n] = (f32x4){0.f, 0.f, 0.f, 0.f};
        cur = nxt; cA = nA; cB = nB; ++ui;
        if constexpr (ALIGN_EPI) { if (wr == 1) PG8_BAR; }
    }
    PG8_WAIT_V(0);
    if constexpr (!ALIGN_EPI) { if (wr == 0) PG8_BAR; }
    PG8_BAR;
    if constexpr (Epi::AFTER_DRAIN) { E.fused(acc, cur, wr, wc, fr, fq, lds, wid, lane); S.done(cur); }
#undef PG8_SA
#undef PG8_SB
#undef PG8_STAGE
#undef PG8_LDA
#undef PG8_LDB
#undef PG8_MMA
#undef PG8_WAIT_V
#undef PG8_WAIT_L
#undef PG8_BAR
#undef PG8_SCHED
}
}

#ifndef PG8_SP2
#define PG8_SP2 true
#endif
#ifndef PG8_ALIGN
#define PG8_ALIGN true
#endif
constexpr int NWAVES = 8;
constexpr int NB = 4, S = 4096, D = 4096, M = NB * S, DEPTH = 2;
constexpr int MEM_LEN = 256, MM = NB * MEM_LEN;
constexpr int ATTN_W = 2048, NH = 16, HD = 128, CONV_W = 1024, SSM_W = 1024, CONV_K = 31, SSM_G = 64, SSM_CH = 16, SSM_P = 64;
constexpr int MEM_W = 512, NMH = 4, DFF = 16384, IN_W = 9216;
constexpr float EPS = 1e-6f;
constexpr float QK_SCALE = 0.08838834764831845f;
constexpr size_t OW_IN = 0, OW_OUT = OW_IN + (size_t)IN_W * D, OW_CQ = OW_OUT + (size_t)D * D, OW_CKV = OW_CQ + (size_t)MEM_W * D, OW_CO = OW_CKV + (size_t)2 * MEM_W * D,
                 OW_UP = OW_CO + (size_t)D * MEM_W, OW_DOWN = OW_UP + (size_t)DFF * D, OW_GLU = OW_DOWN + (size_t)D * DFF, W_LAYER = OW_GLU + (size_t)SSM_W * SSM_W;
static_assert(W_LAYER == 198180864ull, "weight block");
constexpr size_t MiB = 1u << 20;
constexpr size_t WS_CTL = 0, CTL_ZERO_BYTES = 1 * MiB;
constexpr size_t WS_W = 1 * MiB;
constexpr size_t WS_XN = WS_W + (size_t)DEPTH * W_LAYER * 2;
constexpr size_t WS_MEMN = WS_XN + (size_t)M * D * 2;
constexpr size_t WS_KV = WS_MEMN + (size_t)DEPTH * MM * D * 2;
constexpr size_t WS_QC = WS_KV + (size_t)DEPTH * MM * 1024 * 2;
constexpr size_t WS_OC = WS_QC + (size_t)M * MEM_W * 2;
constexpr size_t WS_R = WS_OC + (size_t)M * MEM_W * 2;
constexpr size_t R_QKVC = 0;
constexpr size_t R_ATT = R_QKVC + (size_t)9 * M * 1024 * 2;
constexpr size_t R_Z = R_ATT + (size_t)3 * M * ATTN_W * 2;
constexpr size_t R_SG = R_Z + (size_t)M * SSM_W * 2;
constexpr size_t R_MIXED = R_SG + (size_t)M * SSM_W * 2;
constexpr size_t R_LSE = R_MIXED + (size_t)M * D * 2;
constexpr size_t R_PS = R_LSE + (size_t)3 * M * NH * 4;
constexpr size_t R_RS = R_PS + (size_t)64 * M * 4;
constexpr size_t R_END = R_RS + (size_t)M * 4;
constexpr size_t R_H = 0;
static_assert((size_t)M * DFF * 2 <= R_END, "h overlay");
constexpr size_t WS_END = WS_R + R_END;
constexpr size_t WS_XN2 = WS_END;
constexpr size_t WS_END2 = WS_XN2 + (size_t)M * D * 2;
constexpr size_t PSX_BYTES = (size_t)64 * M * 4, RSX_BYTES = (size_t)M * 4;
constexpr size_t WS_PSX = WS_END2, WS_RSX = WS_PSX + 3 * DEPTH * PSX_BYTES, WS_END3 = WS_RSX + 3 * DEPTH * RSX_BYTES;
static_assert(WS_XN % 256 == 0 && WS_R % 256 == 0, "alignment");
constexpr int CW_BAR = 4096;
constexpr int RING_OFF = 0, RING_BYTES = 131072;
constexpr int LDSCTL_OFF = 147456, MISC_OFF = LDSCTL_OFF + 320;
constexpr int LDS_BYTES = 163840;
constexpr int NPH_LAYER = 13, NPH = 1 + DEPTH * NPH_LAYER;

#define GAS __attribute__((address_space(1)))
#define LAS __attribute__((address_space(3)))
typedef unsigned short bf16;
typedef unsigned v4u __attribute__((ext_vector_type(4)));
typedef unsigned v2u __attribute__((ext_vector_type(2)));
typedef float f32x4 __attribute__((ext_vector_type(4)));
typedef GAS unsigned gu32;
#define LDS_WAIT() asm volatile("s_waitcnt lgkmcnt(0)" ::: "memory")
#define VM_WAIT() asm volatile("s_waitcnt vmcnt(0)" ::: "memory")
__device__ __forceinline__ unsigned f2bf(float f) { unsigned u = __builtin_bit_cast(unsigned, f); return (u + 0x7fffu + ((u >> 16) & 1u)) >> 16; }
__device__ __forceinline__ unsigned pk2(float lo, float hi) { return f2bf(lo) | (f2bf(hi) << 16); }
__device__ __forceinline__ float blo(unsigned w) { return __uint_as_float(w << 16); }
__device__ __forceinline__ float bhi(unsigned w) { return __uint_as_float(w & 0xffff0000u); }
__device__ __forceinline__ float sigm(float x) { return 1.0f / (1.0f + __expf(-x)); }

#define XB_TMO      128
#define XB_XCNT(j)  (256  + 64 * (j))
#define XB_XSUB(j)  (1280 + 64 * (j))
#define XB_XGEN(j)  (2304 + 64 * (j))
#define XB_TOP      3328
#define XB_TOPGEN   3392
#define XCD_BAR_WORDS 3456
#define XB_SPIN_CAP (1u << 18)
#ifndef XB_ACQ_SCOPE
#define XB_ACQ_SCOPE "agent"
#endif

__device__ __forceinline__ unsigned xb_ld(unsigned* p)              { return __hip_atomic_load((GAS unsigned*)p, __ATOMIC_RELAXED, __HIP_MEMORY_SCOPE_AGENT); }
__device__ __forceinline__ unsigned xb_add(unsigned* p, unsigned v) { return __hip_atomic_fetch_add((GAS unsigned*)p, v, __ATOMIC_RELAXED, __HIP_MEMORY_SCOPE_AGENT); }
__device__ __forceinline__ unsigned xb_xcc_id() { return (unsigned)__builtin_amdgcn_s_getreg((3 << 11) | 20) & 0xFu; }
#define XB_SPIN(cond, bar) do { unsigned _sp = 0; while (cond) { __builtin_amdgcn_s_sleep(1); \
    if ((++_sp & 255u) == 0u) { if (xb_ld(&(bar)[XB_TMO])) break; if (_sp > XB_SPIN_CAP) { (void)xb_add(&(bar)[XB_TMO], 1u); break; } } } } while (0)

struct XcdBarrier {
    unsigned* bar; unsigned x;
    volatile LAS unsigned* st;
};

__device__ __forceinline__ XcdBarrier xcd_barrier_post(unsigned* bar, volatile LAS unsigned* st) {
    XcdBarrier b; b.bar = bar; b.x = xb_xcc_id(); b.st = st;
    if (threadIdx.x == 0) (void)xb_add(&bar[XB_XCNT(b.x)], 1u);
    return b;
}
__device__ __forceinline__ void xcd_barrier_complete(unsigned* bar, unsigned x, unsigned& nloc, unsigned& nx) {
    const unsigned G = gridDim.x * gridDim.y * gridDim.z;
    unsigned sum, cnt, mine, sp = 0u;
    for (;;) {
        sum = 0u; cnt = 0u; mine = 0u;
#pragma unroll
        for (unsigned j = 0; j < 16; ++j) { const unsigned c = xb_ld(&bar[XB_XCNT(j)]); sum += c; cnt += (c > 0u) ? 1u : 0u; mine = (j == x) ? c : mine; }
        if (sum == G) break;
        __builtin_amdgcn_s_sleep(1);
        if ((++sp & 255u) == 0u) { if (xb_ld(&bar[XB_TMO])) break; if (sp > XB_SPIN_CAP) { (void)xb_add(&bar[XB_TMO], 1u); break; } }
    }
    nloc = mine > 0u ? mine : 1u; nx = cnt > 0u ? cnt : 1u;
}

__device__ __forceinline__ void xcd_barrier(const XcdBarrier& b) {
    asm volatile("s_waitcnt vmcnt(0)" ::: "memory");
    __syncthreads();
    if (threadIdx.x == 0) {
        unsigned* bar = b.bar;
        __builtin_amdgcn_s_waitcnt(0);
        unsigned nloc = b.st[0], nx = b.st[1];
        if (nloc == 0u) { xcd_barrier_complete(bar, b.x, nloc, nx); b.st[0] = nloc; b.st[1] = nx; }
        const unsigned old = xb_add(&bar[XB_XSUB(b.x)], 1u);
        const unsigned gen = old / nloc;
        if (old + 1u == (gen + 1u) * nloc) {
            __builtin_amdgcn_fence(__ATOMIC_RELEASE, "agent");
            asm volatile("s_waitcnt vmcnt(0)" ::: "memory");
            const unsigned og = xb_add(&bar[XB_TOP], 1u);
            const unsigned tg = og / nx;
            if (og + 1u == (tg + 1u) * nx) xb_add(&bar[XB_TOPGEN], 1u);
            else XB_SPIN(xb_ld(&bar[XB_TOPGEN]) == tg, bar);
            __builtin_amdgcn_fence(__ATOMIC_ACQUIRE, XB_ACQ_SCOPE);
            xb_add(&bar[XB_XGEN(b.x)], 1u);
            asm volatile("s_waitcnt vmcnt(0)" ::: "memory");
        } else {
            XB_SPIN(xb_ld(&bar[XB_XGEN(b.x)]) == gen, bar);
            __builtin_amdgcn_fence(__ATOMIC_ACQUIRE, XB_ACQ_SCOPE);
            asm volatile("s_waitcnt vmcnt(0)" ::: "memory");
        }
    }
    __syncthreads();
}

#define SWZ_XOR(v, m) __builtin_bit_cast(float, __builtin_amdgcn_ds_swizzle(__builtin_bit_cast(int, (v)), ((m) << 10) | 0x1f))
__device__ __forceinline__ float xor32_sum(float v) { const auto r = __builtin_amdgcn_permlane32_swap(__builtin_bit_cast(unsigned, v), __builtin_bit_cast(unsigned, v), false, false); return __builtin_bit_cast(float, r[0]) + __builtin_bit_cast(float, r[1]); }
__device__ __forceinline__ float xor32_max(float v) { const auto r = __builtin_amdgcn_permlane32_swap(__builtin_bit_cast(unsigned, v), __builtin_bit_cast(unsigned, v), false, false); return fmaxf(__builtin_bit_cast(float, r[0]), __builtin_bit_cast(float, r[1])); }
__device__ __forceinline__ int opq_lane_id() { int l = (int)__builtin_amdgcn_mbcnt_hi(~0u, __builtin_amdgcn_mbcnt_lo(~0u, 0u)); asm volatile("" : "+v"(l)); return l; }
__device__ __forceinline__ float bperm_xor(float v, int l, int m) { return __builtin_bit_cast(float, __builtin_amdgcn_ds_bpermute((l ^ m) << 2, __builtin_bit_cast(int, v))); }
__device__ __forceinline__ float wave_sum(float v) {
    const int l = opq_lane_id();
#pragma unroll
    for (int o = 1; o < 64; o <<= 1) v += bperm_xor(v, l, o);
    return v;
}
__device__ __forceinline__ float wave_max(float v) {
    const int l = opq_lane_id();
#pragma unroll
    for (int o = 1; o < 64; o <<= 1) v = fmaxf(v, bperm_xor(v, l, o));
    return v;
}
#define X32SUM(v) ((v) + bperm_xor((v), opq_lane_id(), 32))
#define X32MAX(v) fmaxf((v), bperm_xor((v), opq_lane_id(), 32))
__device__ __forceinline__ void p0_transpose_item(const float* W, int K, int N, bf16* WT, int row_off, LAS float* scr, int item, int lane) {
    const int nblk = N / 32, kb = item / nblk, nb = item % nblk, k0 = 64 * kb, n0 = 32 * nb;
#pragma unroll 8
    for (int i = 0; i < 32; ++i) { const int kk = 2 * i + (lane >> 5); scr[kk * 33 + (lane & 31)] = W[(size_t)(k0 + kk) * N + n0 + (lane & 31)]; }
    LDS_WAIT(); asm volatile("" ::: "memory");
    const int c = lane & 7;
#pragma unroll
    for (int j = 0; j < 4; ++j) { const int n = (lane >> 3) + 8 * j; const LAS float* s = scr + (8 * c) * 33 + n;
        v4u o; o.x = pk2(s[0 * 33], s[1 * 33]); o.y = pk2(s[2 * 33], s[3 * 33]); o.z = pk2(s[4 * 33], s[5 * 33]); o.w = pk2(s[6 * 33], s[7 * 33]);
        *(GAS v4u*)(WT + (size_t)(row_off + n0 + n) * K + k0 + 8 * c) = o; }
    LDS_WAIT(); asm volatile("" ::: "memory");
}
__device__ __forceinline__ void rmsnorm_rows(const float* x, const float* g, bf16* out, int rows, int gw, int NGW, int lane) {
    for (int m = gw; m < rows; m += NGW) {
        const GAS f32x4* xr = (const GAS f32x4*)(x + (size_t)m * D) + lane;
        f32x4 v[16]; float s = 0.f;
#pragma unroll
        for (int j = 0; j < 16; ++j) { v[j] = xr[64 * j]; s += (v[j].x * v[j].x + v[j].y * v[j].y) + (v[j].z * v[j].z + v[j].w * v[j].w); }
        const float r = 1.0f / sqrtf(wave_sum(s) * (1.f / D) + EPS);
        const GAS f32x4* g4 = (const GAS f32x4*)g + lane;
        GAS unsigned long long* o8 = (GAS unsigned long long*)(out + (size_t)m * D) + lane;
#pragma unroll
        for (int j = 0; j < 16; ++j) { const f32x4 gg = g4[64 * j];
            o8[64 * j] = (unsigned long long)pk2(v[j].x * r * gg.x, v[j].y * r * gg.y) | ((unsigned long long)pk2(v[j].z * r * gg.z, v[j].w * r * gg.w) << 32); }
    }
}

__device__ __forceinline__ void xb_rows(const float* x, bf16* xb, float* rs, int gw, int NGW, int lane) {
    const int rpw = (M + NGW - 1) / NGW;
    for (int m = gw * rpw; m < M && m < (gw + 1) * rpw; ++m) {
        const GAS f32x4* xr = (const GAS f32x4*)(x + (size_t)m * D) + lane; GAS unsigned long long* o8 = (GAS unsigned long long*)(xb + (size_t)m * D) + lane; float s = 0.f;
#pragma unroll
        for (int j = 0; j < 16; ++j) { const f32x4 v = xr[64 * j]; s += (v.x * v.x + v.y * v.y) + (v.z * v.z + v.w * v.w);
            o8[64 * j] = (unsigned long long)pk2(v.x, v.y) | ((unsigned long long)pk2(v.z, v.w) << 32); }
        s = wave_sum(s);
        if (lane == 0) ((GAS float*)rs)[m] = 1.0f / sqrtf(s * (1.f / D) + EPS);
    }
}
__device__ __forceinline__ void reduce_rows8(const float* ps, float* rs, int gw, int NGW) {
    const int lane = opq_lane_id(), rsub = lane >> 3, part = lane & 7;
    for (int r0 = gw * 8; r0 < M; r0 += NGW * 8) { const int row = r0 + rsub; float v[8];
#pragma unroll
        for (int j = 0; j < 8; ++j) v[j] = ((const GAS float*)ps)[(size_t)(8 * part + j) * M + row];
        float s = ((v[0] + v[1]) + (v[2] + v[3])) + ((v[4] + v[5]) + (v[6] + v[7]));
        s += bperm_xor(s, lane, 1); s += bperm_xor(s, lane, 2); s += bperm_xor(s, lane, 4);
        if (part == 0) ((GAS float*)rs)[row] = 1.0f / sqrtf(s * (1.f / D) + EPS); }
}
__device__ __forceinline__ void reduce_rows(const float* ps, float* rs, int gw, int NGW, int lane) {
    for (int row = gw * 64 + lane; row < M; row += NGW * 64) { float s = 0.f;
#pragma unroll 8
        for (int j = 0; j < 64; ++j) s += ((const GAS float*)ps)[(size_t)j * M + row];
        ((GAS float*)rs)[row] = 1.0f / sqrtf(s * (1.f / D) + EPS); }
}

__device__ __forceinline__ void reduce_rows_wg(const float* ps, float* rs, int r0, int tid, LAS float* sc) {
    const int row = r0 + (tid & 255), part = tid >> 8; float s = 0.f;
#pragma unroll 8
    for (int j = 0; j < 32; ++j) s += ((const GAS float*)ps)[(size_t)(32 * part + j) * M + row];
    if (part == 1) sc[tid & 255] = s;
    LDS_WAIT(); __syncthreads();
    if (part == 0) ((GAS float*)rs)[row] = 1.0f / sqrtf((s + sc[tid & 255]) * (1.f / D) + EPS);
    VM_WAIT(); __syncthreads();
}

template <int MODE> __device__ __forceinline__ size_t attn_keyoff(int r, int j, int b, int ts, int h, bool& valid) {
    if (MODE == 0) {
        int tk; if (r < 6) { const int d = 1 << (2 * (r >> 1)); const int dist = 1 + 64 * (r & 1) + j; tk = ts - dist * d; valid = tk >= 0; } else { tk = ts; valid = j < 3; }
        if (!valid) tk = ts;
        return (size_t)(h >> 3) * M * 1024 + (size_t)(b * S + tk) * 1024 + (h & 7) * 128;
    } else { valid = true; return (size_t)(b * MEM_LEN + 64 * r + j) * 1024 + h * 128; }
}
template <int MODE> __device__ __forceinline__ void attn_naive_item(int item, const bf16* Qb, const bf16* Kb, const bf16* Vb, const float* gq, const float* gk, bf16* Ob, LAS float* qn, int lane) {
    constexpr int NR = MODE == 0 ? 7 : 4;
    const int t = item & (M - 1), h = item >> 14, b = t >> 12, ts = t & (S - 1);
    const size_t qoff = MODE == 0 ? (size_t)(h >> 3) * M * 1024 + (size_t)t * 1024 + (h & 7) * 128 : (size_t)t * MEM_W + h * 128;
    const size_t ooff = MODE == 0 ? (size_t)t * ATTN_W + h * 128 : (size_t)t * MEM_W + h * 128;
    {
        const unsigned qw = *(const GAS unsigned*)(Qb + qoff + 2 * lane);
        const float q0 = blo(qw), q1 = bhi(qw);
        const float rq = 1.0f / sqrtf(wave_sum(q0 * q0 + q1 * q1) * (1.f / HD) + EPS);
        qn[2 * lane] = q0 * rq * gq[2 * lane] * gk[2 * lane] * QK_SCALE; qn[2 * lane + 1] = q1 * rq * gq[2 * lane + 1] * gk[2 * lane + 1] * QK_SCALE;
        LDS_WAIT();
    }
    const LAS f32x4* qn4 = (const LAS f32x4*)qn;
    float sc[NR];
#pragma unroll
    for (int r = 0; r < NR; ++r) {
        bool valid; const size_t off = attn_keyoff<MODE>(r, lane, b, ts, h, valid);
        const GAS v4u* kp = (const GAS v4u*)(Kb + off);
        float dot = 0.f, ss = 0.f;
#pragma unroll
        for (int c = 0; c < 16; ++c) { const v4u kk = kp[c]; const f32x4 qa = qn4[2 * c], qb = qn4[2 * c + 1];
            const float k0 = blo(kk.x), k1 = bhi(kk.x), k2 = blo(kk.y), k3 = bhi(kk.y), k4 = blo(kk.z), k5 = bhi(kk.z), k6 = blo(kk.w), k7 = bhi(kk.w);
            dot += (k0 * qa.x + k1 * qa.y) + (k2 * qa.z + k3 * qa.w) + (k4 * qb.x + k5 * qb.y) + (k6 * qb.z + k7 * qb.w);
            ss += (k0 * k0 + k1 * k1) + (k2 * k2 + k3 * k3) + (k4 * k4 + k5 * k5) + (k6 * k6 + k7 * k7); }
        sc[r] = valid ? dot * (1.0f / sqrtf(ss * (1.f / HD) + EPS)) : -1e30f;
    }
    float mx = sc[0];
#pragma unroll
    for (int r = 1; r < NR; ++r) mx = fmaxf(mx, sc[r]);
    mx = wave_max(mx);
    float p[NR]; float ls = 0.f;
#pragma unroll
    for (int r = 0; r < NR; ++r) { p[r] = __expf(sc[r] - mx); ls += p[r]; }
    const float inv = 1.0f / wave_sum(ls);
    const int g4 = lane >> 4, li = lane & 15;
    float acc[8];
#pragma unroll
    for (int k = 0; k < 8; ++k) acc[k] = 0.f;
#pragma unroll
    for (int r = 0; r < NR; ++r) {
#pragma unroll 4
        for (int i = 0; i < 16; ++i) { const int j = 4 * i + g4; const float pj = __shfl(p[r], j);
            bool valid; const size_t off = attn_keyoff<MODE>(r, j, b, ts, h, valid);
            const v4u vv = *(const GAS v4u*)(Vb + off + 8 * li);
            acc[0] += pj * blo(vv.x); acc[1] += pj * bhi(vv.x); acc[2] += pj * blo(vv.y); acc[3] += pj * bhi(vv.y);
            acc[4] += pj * blo(vv.z); acc[5] += pj * bhi(vv.z); acc[6] += pj * blo(vv.w); acc[7] += pj * bhi(vv.w); }
    }
#pragma unroll
    for (int k = 0; k < 8; ++k) { acc[k] += __shfl_xor(acc[k], 16); acc[k] += __shfl_xor(acc[k], 32); acc[k] *= inv; }
    if (g4 == 0) { v4u o; o.x = pk2(acc[0], acc[1]); o.y = pk2(acc[2], acc[3]); o.z = pk2(acc[4], acc[5]); o.w = pk2(acc[6], acc[7]); *(GAS v4u*)(Ob + ooff + 8 * li) = o; }
    LDS_WAIT();
}

typedef short bf16x8v __attribute__((ext_vector_type(8)));
typedef float f32x16 __attribute__((ext_vector_type(16)));
typedef short s16x4v __attribute__((ext_vector_type(4)));
typedef float f32x2v __attribute__((ext_vector_type(2)));
typedef __bf16 bf16x2v __attribute__((ext_vector_type(2)));
__device__ __forceinline__ unsigned cvtpk(float lo, float hi) { f32x2v v = {lo, hi}; bf16x2v b = __builtin_convertvector(v, bf16x2v); return __builtin_bit_cast(unsigned, b); }
__device__ __forceinline__ unsigned vt_off(unsigned row, unsigned ch) { return 256u * row + 16u * (ch ^ (((row & 3u) << 2) | ((row >> 2) & 3u))); }
__device__ __forceinline__ s16x4v vtr(const LAS unsigned char* p) { return __builtin_bit_cast(s16x4v, __builtin_amdgcn_ds_read_tr16_b64_v4i16((LAS s16x4v*)p)); }
__device__ __forceinline__ float sumsq8(v4u w) { const float a0 = blo(w.x), a1 = bhi(w.x), a2 = blo(w.y), a3 = bhi(w.y), a4 = blo(w.z), a5 = bhi(w.z), a6 = blo(w.w), a7 = bhi(w.w);
    return ((a0 * a0 + a1 * a1) + (a2 * a2 + a3 * a3)) + ((a4 * a4 + a5 * a5) + (a6 * a6 + a7 * a7)); }
constexpr float LOG2E = 1.4426950408889634f;
template <int MODE> __device__ __forceinline__ void attn_mfma_item(int item, const bf16* Qb, const bf16* Kb, const bf16* Vb, bf16* Ob, float* LSE, const LAS float* G2, LAS unsigned char* wl, int lane) {
    const int rr = lane & 31, hh = lane >> 5;
    int h, b, d = 1, r = 0, qt, pat = 0;
    if (MODE == 0) { const int j = item & 127; b = (item >> 7) & 3; h = (item >> 9) & 15; pat = item >> 13; d = 1 << (2 * pat); const int per = 128 >> (2 * pat); r = j / per; qt = j - r * per; }
    else { const int tt = item & 511; h = item >> 9; b = tt >> 7; qt = tt & 127; }
    const size_t hso = MODE == 0 ? (size_t)(h >> 3) * M * 1024 + (h & 7) * 128 + 64 * hh : (size_t)h * 128 + 64 * hh;
    const int qtok = MODE == 0 ? b * S + (32 * qt + rr) * d + r : b * S + 32 * qt + rr;
    bf16x8v Qf[8];
    {   const GAS v4u* qp = (const GAS v4u*)(Qb + (MODE == 0 ? (size_t)qtok * 1024 : (size_t)qtok * MEM_W) + hso);
        v4u qraw[8]; float ss = 0.f;
#pragma unroll
        for (int ks = 0; ks < 8; ++ks) { qraw[ks] = qp[ks]; ss += sumsq8(qraw[ks]); }
        ss = X32SUM(ss);
        const float rq = 1.0f / sqrtf(ss * (1.f / HD) + EPS);
        const LAS f32x4* g4 = (const LAS f32x4*)(G2 + 64 * hh);
#pragma unroll
        for (int ks = 0; ks < 8; ++ks) { const f32x4 ga = g4[2 * ks], gb = g4[2 * ks + 1]; const v4u w = qraw[ks]; v4u o;
            o.x = cvtpk(blo(w.x) * rq * ga.x, bhi(w.x) * rq * ga.y); o.y = cvtpk(blo(w.y) * rq * ga.z, bhi(w.y) * rq * ga.w);
            o.z = cvtpk(blo(w.z) * rq * gb.x, bhi(w.z) * rq * gb.y); o.w = cvtpk(blo(w.w) * rq * gb.z, bhi(w.w) * rq * gb.w);
            Qf[ks] = __builtin_bit_cast(bf16x8v, o); }
    }
    f32x16 O0, O1, O2, O3;
#pragma unroll
    for (int i = 0; i < 16; ++i) { O0[i] = 0.f; O1[i] = 0.f; O2[i] = 0.f; O3[i] = 0.f; }
    float mrun = -1e30f, lrun = 0.f;
    LAS float* RK = (LAS float*)(wl + 8192);
    const unsigned q_ = (lane & 15) >> 2, p_ = lane & 3, blk = (lane >> 4) & 1;
    const int kt_lo = MODE == 0 ? (qt < 4 ? 4 - qt : 0) : 0, kt_hi = MODE == 0 ? 4 : 7;
#define ATT_KTOK(kt_) (MODE == 0 ? b * S + (32 * qt - 128 + 32 * (kt_) + rr) * d + r : b * MEM_LEN + 32 * (kt_) + rr)
    v4u kraw[8], vraw[8];
    {   const int ktok = ATT_KTOK(kt_lo);
        const GAS v4u* kp = (const GAS v4u*)(Kb + (size_t)ktok * 1024 + hso); const GAS v4u* vp = (const GAS v4u*)(Vb + (size_t)ktok * 1024 + hso);
#pragma unroll
        for (int ks = 0; ks < 8; ++ks) kraw[ks] = kp[ks];
#if ATT_PREFETCH != 2
#pragma unroll
        for (int ks = 0; ks < 8; ++ks) vraw[ks] = vp[ks];
#else
        (void)vp;
#endif
    }
    for (int kt = kt_lo; kt <= kt_hi; ++kt) {
#if ATT_PREFETCH == 2
        {   const GAS v4u* vp = (const GAS v4u*)(Vb + (size_t)ATT_KTOK(kt) * 1024 + hso);
#pragma unroll
            for (int ks = 0; ks < 8; ++ks) vraw[ks] = vp[ks]; }
#endif
#if !ATT_PREFETCH
        if (kt > kt_lo) { const int ktok = ATT_KTOK(kt);
            const GAS v4u* kp = (const GAS v4u*)(Kb + (size_t)ktok * 1024 + hso); const GAS v4u* vp = (const GAS v4u*)(Vb + (size_t)ktok * 1024 + hso);
#pragma unroll
            for (int ks = 0; ks < 8; ++ks) kraw[ks] = kp[ks];
#pragma unroll
            for (int ks = 0; ks < 8; ++ks) vraw[ks] = vp[ks]; }
#endif
        float ss = 0.f;
#pragma unroll
        for (int ks = 0; ks < 8; ++ks) ss += sumsq8(kraw[ks]);
        ss = X32SUM(ss);
        const float rk = 1.0f / sqrtf(ss * (1.f / HD) + EPS);
        if (hh == 0) RK[rr] = rk;
        f32x16 sacc;
#pragma unroll
        for (int i = 0; i < 16; ++i) sacc[i] = 0.f;
#pragma unroll
        for (int ks = 0; ks < 8; ++ks) sacc = __builtin_amdgcn_mfma_f32_32x32x16_bf16(__builtin_bit_cast(bf16x8v, kraw[ks]), Qf[ks], sacc, 0, 0, 0);
#if ATT_PREFETCH == 2
        if (kt < kt_hi) { const GAS v4u* kp = (const GAS v4u*)(Kb + (size_t)ATT_KTOK(kt + 1) * 1024 + hso);
#pragma unroll
            for (int ks = 0; ks < 8; ++ks) kraw[ks] = kp[ks]; }
#endif
#pragma unroll
        for (int ks = 0; ks < 8; ++ks) *(LAS v4u*)(wl + vt_off((unsigned)rr, (unsigned)(8 * hh + ks))) = vraw[ks];
        if (ATT_PREFETCH == 1 && kt < kt_hi) { const int ktok = ATT_KTOK(kt + 1);
            const GAS v4u* kp = (const GAS v4u*)(Kb + (size_t)ktok * 1024 + hso); const GAS v4u* vp = (const GAS v4u*)(Vb + (size_t)ktok * 1024 + hso);
#pragma unroll
            for (int ks = 0; ks < 8; ++ks) kraw[ks] = kp[ks];
#pragma unroll
            for (int ks = 0; ks < 8; ++ks) vraw[ks] = vp[ks]; }
        LDS_WAIT();
        float sv[16];
#pragma unroll
        for (int g = 0; g < 4; ++g) { const f32x4 r4 = *(const LAS f32x4*)(RK + 8 * g + 4 * hh);
            sv[4 * g + 0] = sacc[4 * g + 0] * r4.x; sv[4 * g + 1] = sacc[4 * g + 1] * r4.y; sv[4 * g + 2] = sacc[4 * g + 2] * r4.z; sv[4 * g + 3] = sacc[4 * g + 3] * r4.w; }
        if (MODE == 0) {
            if (kt == 0) {
#pragma unroll
                for (int i = 0; i < 16; ++i) { const int kk = (i & 3) + 8 * (i >> 2) + 4 * hh; sv[i] = (kk >= rr) ? sv[i] : -1e30f; } }
            if (kt == 4) {
#pragma unroll
                for (int i = 0; i < 16; ++i) { const int kk = (i & 3) + 8 * (i >> 2) + 4 * hh; sv[i] = (kk <= rr) ? sv[i] : -1e30f; } }
        }
        float mt = sv[0];
#pragma unroll
        for (int i = 1; i < 16; ++i) mt = fmaxf(mt, sv[i]);
        mt = X32MAX(mt);
        const float mn = fmaxf(mrun, mt), alpha = __builtin_amdgcn_exp2f(mrun - mn); mrun = mn;
        float ps = 0.f;
#pragma unroll
        for (int i = 0; i < 16; ++i) { sv[i] = __builtin_amdgcn_exp2f(sv[i] - mn); ps += sv[i]; }
        ps = X32SUM(ps);
        lrun = lrun * alpha + ps;
#pragma unroll
        for (int i = 0; i < 16; ++i) { O0[i] *= alpha; O1[i] *= alpha; O2[i] *= alpha; O3[i] *= alpha; }
        v4u pw0, pw1;
        pw0.x = cvtpk(sv[0], sv[1]); pw0.y = cvtpk(sv[2], sv[3]); pw0.z = cvtpk(sv[4], sv[5]); pw0.w = cvtpk(sv[6], sv[7]);
        pw1.x = cvtpk(sv[8], sv[9]); pw1.y = cvtpk(sv[10], sv[11]); pw1.z = cvtpk(sv[12], sv[13]); pw1.w = cvtpk(sv[14], sv[15]);
        const bf16x8v P0 = __builtin_bit_cast(bf16x8v, pw0), P1 = __builtin_bit_cast(bf16x8v, pw1);
#define ATT_VFRAG(c, s) ({ const s16x4v lo_ = vtr(wl + vt_off(16u * (s) + 4u * hh + q_, 4u * (c) + 2u * blk + (p_ >> 1)) + 8u * (p_ & 1u)); \
                           const s16x4v hi_ = vtr(wl + vt_off(16u * (s) + 8u + 4u * hh + q_, 4u * (c) + 2u * blk + (p_ >> 1)) + 8u * (p_ & 1u)); \
                           (bf16x8v){lo_[0], lo_[1], lo_[2], lo_[3], hi_[0], hi_[1], hi_[2], hi_[3]}; })
        O0 = __builtin_amdgcn_mfma_f32_32x32x16_bf16(ATT_VFRAG(0, 0), P0, O0, 0, 0, 0); O0 = __builtin_amdgcn_mfma_f32_32x32x16_bf16(ATT_VFRAG(0, 1), P1, O0, 0, 0, 0);
        O1 = __builtin_amdgcn_mfma_f32_32x32x16_bf16(ATT_VFRAG(1, 0), P0, O1, 0, 0, 0); O1 = __builtin_amdgcn_mfma_f32_32x32x16_bf16(ATT_VFRAG(1, 1), P1, O1, 0, 0, 0);
        O2 = __builtin_amdgcn_mfma_f32_32x32x16_bf16(ATT_VFRAG(2, 0), P0, O2, 0, 0, 0); O2 = __builtin_amdgcn_mfma_f32_32x32x16_bf16(ATT_VFRAG(2, 1), P1, O2, 0, 0, 0);
        O3 = __builtin_amdgcn_mfma_f32_32x32x16_bf16(ATT_VFRAG(3, 0), P0, O3, 0, 0, 0); O3 = __builtin_amdgcn_mfma_f32_32x32x16_bf16(ATT_VFRAG(3, 1), P1, O3, 0, 0, 0);
#undef ATT_VFRAG
        LDS_WAIT();
    }
#undef ATT_KTOK
    const float inv = 1.0f / lrun;
    bf16* orow = MODE == 0 ? Ob + (size_t)pat * M * ATTN_W + (size_t)qtok * ATTN_W + h * 128 : Ob + (size_t)qtok * MEM_W + h * 128;
#pragma unroll
    for (int g = 0; g < 4; ++g) {
        v2u w;
        w.x = cvtpk(O0[4 * g] * inv, O0[4 * g + 1] * inv); w.y = cvtpk(O0[4 * g + 2] * inv, O0[4 * g + 3] * inv); *(GAS v2u*)(orow + 0 + 8 * g + 4 * hh) = w;
        w.x = cvtpk(O1[4 * g] * inv, O1[4 * g + 1] * inv); w.y = cvtpk(O1[4 * g + 2] * inv, O1[4 * g + 3] * inv); *(GAS v2u*)(orow + 32 + 8 * g + 4 * hh) = w;
        w.x = cvtpk(O2[4 * g] * inv, O2[4 * g + 1] * inv); w.y = cvtpk(O2[4 * g + 2] * inv, O2[4 * g + 3] * inv); *(GAS v2u*)(orow + 64 + 8 * g + 4 * hh) = w;
        w.x = cvtpk(O3[4 * g] * inv, O3[4 * g + 1] * inv); w.y = cvtpk(O3[4 * g + 2] * inv, O3[4 * g + 3] * inv); *(GAS v2u*)(orow + 96 + 8 * g + 4 * hh) = w;
    }
    if (MODE == 0 && hh == 0) ((GAS float*)LSE)[(((size_t)pat * NB + b) * NH + h) * S + r * (S / d) + 32 * qt + rr] = mrun + __builtin_amdgcn_logf(lrun);
}

typedef __amdgpu_buffer_rsrc_t brsrc_t;
__device__ __forceinline__ brsrc_t mk_rsrc(const void* base, unsigned bytes) { return __builtin_amdgcn_make_buffer_rsrc((void*)base, 0, (int)bytes, 0x00020000); }
__device__ __forceinline__ v4u bload(brsrc_t rs, unsigned voff, unsigned soff) { return __builtin_bit_cast(v4u, __builtin_amdgcn_raw_buffer_load_b128(rs, (int)voff, (int)soff, 0)); }
__device__ __forceinline__ void bstore(brsrc_t rs, unsigned voff, unsigned soff, v4u v) { __builtin_amdgcn_raw_buffer_store_b128(__builtin_bit_cast(__attribute__((ext_vector_type(4))) unsigned, v), rs, (int)voff, (int)soff, 0); }
constexpr int KTP = 272;
__device__ __forceinline__ float sumsq8d(v4u w) {
    float s = __builtin_amdgcn_fdot2_f32_bf16(__builtin_bit_cast(bf16x2v, w.x), __builtin_bit_cast(bf16x2v, w.x), 0.0f, false);
    s = __builtin_amdgcn_fdot2_f32_bf16(__builtin_bit_cast(bf16x2v, w.y), __builtin_bit_cast(bf16x2v, w.y), s, false);
    s = __builtin_amdgcn_fdot2_f32_bf16(__builtin_bit_cast(bf16x2v, w.z), __builtin_bit_cast(bf16x2v, w.z), s, false);
    return __builtin_amdgcn_fdot2_f32_bf16(__builtin_bit_cast(bf16x2v, w.w), __builtin_bit_cast(bf16x2v, w.w), s, false); }
__device__ __forceinline__ float sumsq64d(const v4u (&w)[8]) {
    float a0 = 0.f, a1 = 0.f, a2 = 0.f, a3 = 0.f;
#pragma unroll
    for (int k = 0; k < 8; ++k) {
        a0 = __builtin_amdgcn_fdot2_f32_bf16(__builtin_bit_cast(bf16x2v, w[k].x), __builtin_bit_cast(bf16x2v, w[k].x), a0, false);
        a1 = __builtin_amdgcn_fdot2_f32_bf16(__builtin_bit_cast(bf16x2v, w[k].y), __builtin_bit_cast(bf16x2v, w[k].y), a1, false);
        a2 = __builtin_amdgcn_fdot2_f32_bf16(__builtin_bit_cast(bf16x2v, w[k].z), __builtin_bit_cast(bf16x2v, w[k].z), a2, false);
        a3 = __builtin_amdgcn_fdot2_f32_bf16(__builtin_bit_cast(bf16x2v, w[k].w), __builtin_bit_cast(bf16x2v, w[k].w), a3, false); }
    return (a0 + a1) + (a2 + a3);
}
template <int MODE> __device__ __forceinline__ void attn_mfma_item2(int item, brsrc_t rsQ, brsrc_t rsK, brsrc_t rsV, brsrc_t rsO, float* LSE, const LAS float* G2, LAS unsigned char* wl, int lane) {
    const int rr = lane & 31, hh = lane >> 5;
    const int cr = lane >> 4, cc = lane & 15;
    int h, b, d = 1, r = 0, qt, pat = 0;
    if (MODE == 0) { const int j = item & 127; b = (item >> 7) & 3; h = (item >> 9) & 15; pat = item >> 13; d = 1 << (2 * pat); const int per = 128 >> (2 * pat); r = j / per; qt = j - r * per; }
    else { const int tt = item & 511; h = item >> 9; b = tt >> 7; qt = tt & 127; }
    LAS unsigned char* KB = wl; LAS unsigned char* VB = wl + 8704; LAS float* RK = (LAS float*)(wl + 16896);
    const unsigned kpitch = 2048u, qpitch = MODE == 0 ? 2048u : 2u * MEM_W, opitch = MODE == 0 ? 2u * ATTN_W : 2u * MEM_W;
    const unsigned hsK = MODE == 0 ? (unsigned)(h >> 3) * (unsigned)(M * 1024 * 2) + (unsigned)(h & 7) * 256u : (unsigned)h * 256u;
    const unsigned hsO = MODE == 0 ? (unsigned)pat * (unsigned)(M * ATTN_W * 2) + (unsigned)h * 256u : (unsigned)h * 256u;
    const unsigned lK = (unsigned)(cr * d) * kpitch + 16u * cc, lQ = (unsigned)(cr * d) * qpitch + 16u * cc, lO = (unsigned)(cr * d) * opitch + 16u * cc;
    const int qtok0 = MODE == 0 ? b * S + (32 * qt) * d + r : b * S + 32 * qt;
    const int ktokb = MODE == 0 ? b * S + (32 * qt - 128) * d + r : b * MEM_LEN;
    const unsigned wK = (unsigned)(KTP * cr + 16 * cc), rK = (unsigned)(KTP * rr + 128 * hh);
    bf16x8v Qf[8];
    {   v4u st[8];
#pragma unroll
        for (int i = 0; i < 8; ++i) st[i] = bload(rsQ, lQ, hsK + (unsigned)(qtok0 + 4 * i * d) * qpitch);
#pragma unroll
        for (int i = 0; i < 8; ++i) *(LAS v4u*)(KB + wK + 4 * KTP * i) = st[i];
        LDS_WAIT();
        v4u qraw[8]; float ss;
#pragma unroll
        for (int ks = 0; ks < 8; ++ks) qraw[ks] = *(const LAS v4u*)(KB + rK + 16 * ks);
        LDS_WAIT();
        ss = 0.f;
#pragma unroll
        for (int ks = 0; ks < 8; ++ks) ss += sumsq8(qraw[ks]);
        ss = X32SUM(ss);
        const float rq = 1.0f / sqrtf(ss * (1.f / HD) + EPS);
        const LAS f32x4* g4 = (const LAS f32x4*)(G2 + 64 * hh);
#pragma unroll
        for (int ks = 0; ks < 8; ++ks) { const f32x4 ga = g4[2 * ks], gb = g4[2 * ks + 1]; const v4u w = qraw[ks]; v4u o;
            o.x = cvtpk(blo(w.x) * rq * ga.x, bhi(w.x) * rq * ga.y); o.y = cvtpk(blo(w.y) * rq * ga.z, bhi(w.y) * rq * ga.w);
            o.z = cvtpk(blo(w.z) * rq * gb.x, bhi(w.z) * rq * gb.y); o.w = cvtpk(blo(w.w) * rq * gb.z, bhi(w.w) * rq * gb.w);
            Qf[ks] = __builtin_bit_cast(bf16x8v, o); }
    }
    f32x16 O0, O1, O2, O3;
#pragma unroll
    for (int i = 0; i < 16; ++i) { O0[i] = 0.f; O1[i] = 0.f; O2[i] = 0.f; O3[i] = 0.f; }
    float mrun = -1e30f, lrun = 0.f;
    const unsigned q_ = (lane & 15) >> 2, p_ = lane & 3, blk = (lane >> 4) & 1;
    unsigned wV[4];
#pragma unroll
    for (int m = 0; m < 4; ++m) wV[m] = 256u * cr + 16u * ((unsigned)cc ^ ((unsigned)(cr << 2) | (unsigned)m));
    const int kt_lo = MODE == 0 ? (qt < 4 ? 4 - qt : 0) : 0, kt_hi = MODE == 0 ? 4 : 7;
    v4u kst[8], vst[8];
#pragma unroll
    for (int i = 0; i < 8; ++i) kst[i] = bload(rsK, lK, hsK + (unsigned)(ktokb + (32 * kt_lo + 4 * i) * d) * kpitch);
#pragma unroll
    for (int i = 0; i < 8; ++i) vst[i] = bload(rsV, lK, hsK + (unsigned)(ktokb + (32 * kt_lo + 4 * i) * d) * kpitch);
    for (int kt = kt_lo; kt <= kt_hi; ++kt) {
#pragma unroll
        for (int i = 0; i < 8; ++i) *(LAS v4u*)(KB + wK + 4 * KTP * i) = kst[i];
#if ATT_EARLY_PF
#pragma unroll
        for (int i = 0; i < 8; ++i) *(LAS v4u*)(VB + wV[i & 3] + 1024 * i) = vst[i];
        if (kt < kt_hi) {
#pragma unroll
            for (int i = 0; i < 8; ++i) kst[i] = bload(rsK, lK, hsK + (unsigned)(ktokb + (32 * (kt + 1) + 4 * i) * d) * kpitch);
#pragma unroll
            for (int i = 0; i < 8; ++i) vst[i] = bload(rsV, lK, hsK + (unsigned)(ktokb + (32 * (kt + 1) + 4 * i) * d) * kpitch); }
#endif
        LDS_WAIT();
        v4u kraw[8];
#pragma unroll
        for (int ks = 0; ks < 8; ++ks) kraw[ks] = *(const LAS v4u*)(KB + rK + 16 * ks);
        f32x16 sacc;
#if ATT_GRAM
        {   f32x16 gacc;
#pragma unroll
            for (int i = 0; i < 16; ++i) gacc[i] = 0.f;
#pragma unroll
            for (int ks = 0; ks < 8; ++ks) gacc = __builtin_amdgcn_mfma_f32_32x32x16_bf16(__builtin_bit_cast(bf16x8v, kraw[ks]), __builtin_bit_cast(bf16x8v, kraw[ks]), gacc, 0, 0, 0);
            unsigned m0 = (unsigned)(((int)((unsigned)rr << 31)) >> 31), m1 = (unsigned)(((int)((unsigned)rr << 30)) >> 31), m2 = (unsigned)(((int)((unsigned)rr << 28)) >> 31), m3 = (unsigned)(((int)((unsigned)rr << 27)) >> 31);
            asm volatile("" : "+v"(m0), "+v"(m1), "+v"(m2), "+v"(m3));
#define ATT_BSEL(m, a, b) (((a) & ~(m)) | ((b) & (m)))
            unsigned t8[8], t4[4];
#pragma unroll
            for (int j = 0; j < 8; ++j) t8[j] = ATT_BSEL(m0, __float_as_uint(gacc[2 * j]), __float_as_uint(gacc[2 * j + 1]));
#pragma unroll
            for (int j = 0; j < 4; ++j) t4[j] = ATT_BSEL(m1, t8[2 * j], t8[2 * j + 1]);
            const unsigned ta = ATT_BSEL(m2, t4[0], t4[1]), tb = ATT_BSEL(m2, t4[2], t4[3]);
            const float dg = __uint_as_float(ATT_BSEL(m3, ta, tb));
#undef ATT_BSEL
            const float rk = __builtin_amdgcn_rsqf(dg * (1.f / HD) + EPS);
            if (((rr >> 2) & 1) == hh) RK[rr] = rk; }
        __builtin_amdgcn_sched_barrier(0);
#pragma unroll
        for (int i = 0; i < 16; ++i) sacc[i] = 0.f;
#pragma unroll
        for (int ks = 0; ks < 8; ++ks) sacc = __builtin_amdgcn_mfma_f32_32x32x16_bf16(__builtin_bit_cast(bf16x8v, kraw[ks]), Qf[ks], sacc, 0, 0, 0);
#else
        {   float ss = 0.f;
#pragma unroll
            for (int ks = 0; ks < 8; ++ks) ss += sumsq8(kraw[ks]);
            ss = X32SUM(ss);
            const float rk = 1.0f / sqrtf(ss * (1.f / HD) + EPS);
            if (hh == 0) RK[rr] = rk; }
#pragma unroll
        for (int i = 0; i < 16; ++i) sacc[i] = 0.f;
#pragma unroll
        for (int ks = 0; ks < 8; ++ks) sacc = __builtin_amdgcn_mfma_f32_32x32x16_bf16(__builtin_bit_cast(bf16x8v, kraw[ks]), Qf[ks], sacc, 0, 0, 0);
#endif
#if !ATT_EARLY_PF
        if (kt < kt_hi) {
#pragma unroll
            for (int i = 0; i < 8; ++i) kst[i] = bload(rsK, lK, hsK + (unsigned)(ktokb + (32 * (kt + 1) + 4 * i) * d) * kpitch); }
#pragma unroll
        for (int i = 0; i < 8; ++i) *(LAS v4u*)(VB + wV[i & 3] + 1024 * i) = vst[i];
        if (kt < kt_hi) {
#pragma unroll
            for (int i = 0; i < 8; ++i) vst[i] = bload(rsV, lK, hsK + (unsigned)(ktokb + (32 * (kt + 1) + 4 * i) * d) * kpitch); }
#endif
        LDS_WAIT();
        float sv[16];
#pragma unroll
        for (int g = 0; g < 4; ++g) { const f32x4 r4 = *(const LAS f32x4*)(RK + 8 * g + 4 * hh);
            sv[4 * g + 0] = sacc[4 * g + 0] * r4.x; sv[4 * g + 1] = sacc[4 * g + 1] * r4.y; sv[4 * g + 2] = sacc[4 * g + 2] * r4.z; sv[4 * g + 3] = sacc[4 * g + 3] * r4.w; }
        if (MODE == 0) {
            if (kt == 0) {
#pragma unroll
                for (int i = 0; i < 16; ++i) { const int kk = (i & 3) + 8 * (i >> 2) + 4 * hh; sv[i] = (kk >= rr) ? sv[i] : -1e30f; } }
            if (kt == 4) {
#pragma unroll
                for (int i = 0; i < 16; ++i) { const int kk = (i & 3) + 8 * (i >> 2) + 4 * hh; sv[i] = (kk <= rr) ? sv[i] : -1e30f; } }
        }
        float mt = sv[0];
#pragma unroll
        for (int i = 1; i < 16; ++i) mt = fmaxf(mt, sv[i]);
        mt = X32MAX(mt);
        if (ATT_DEFER_MAX == 0 || __builtin_amdgcn_ballot_w64(mt > mrun + 8.f) != 0ull) {
            const float mn = fmaxf(mrun, mt), alpha = __builtin_amdgcn_exp2f(mrun - mn); mrun = mn; lrun *= alpha;
#pragma unroll
            for (int i = 0; i < 16; ++i) { O0[i] *= alpha; O1[i] *= alpha; O2[i] *= alpha; O3[i] *= alpha; } }
        float ps = 0.f;
#pragma unroll
        for (int i = 0; i < 16; ++i) { sv[i] = __builtin_amdgcn_exp2f(sv[i] - mrun); ps += sv[i]; }
#if !ATT_LSUM_LATE
        ps = X32SUM(ps);
#endif
        lrun += ps;
        v4u pw0, pw1;
        pw0.x = cvtpk(sv[0], sv[1]); pw0.y = cvtpk(sv[2], sv[3]); pw0.z = cvtpk(sv[4], sv[5]); pw0.w = cvtpk(sv[6], sv[7]);
        pw1.x = cvtpk(sv[8], sv[9]); pw1.y = cvtpk(sv[10], sv[11]); pw1.z = cvtpk(sv[12], sv[13]); pw1.w = cvtpk(sv[14], sv[15]);
        const bf16x8v P0 = __builtin_bit_cast(bf16x8v, pw0), P1 = __builtin_bit_cast(bf16x8v, pw1);
#define ATT_VFRAG(c, s) ({ const s16x4v lo_ = vtr(VB + vt_off(16u * (s) + 4u * hh + q_, 4u * (c) + 2u * blk + (p_ >> 1)) + 8u * (p_ & 1u)); \
                           const s16x4v hi_ = vtr(VB + vt_off(16u * (s) + 8u + 4u * hh + q_, 4u * (c) + 2u * blk + (p_ >> 1)) + 8u * (p_ & 1u)); \
                           (bf16x8v){lo_[0], lo_[1], lo_[2], lo_[3], hi_[0], hi_[1], hi_[2], hi_[3]}; })
        O0 = __builtin_amdgcn_mfma_f32_32x32x16_bf16(ATT_VFRAG(0, 0), P0, O0, 0, 0, 0); O0 = __builtin_amdgcn_mfma_f32_32x32x16_bf16(ATT_VFRAG(0, 1), P1, O0, 0, 0, 0);
        O1 = __builtin_amdgcn_mfma_f32_32x32x16_bf16(ATT_VFRAG(1, 0), P0, O1, 0, 0, 0); O1 = __builtin_amdgcn_mfma_f32_32x32x16_bf16(ATT_VFRAG(1, 1), P1, O1, 0, 0, 0);
        O2 = __builtin_amdgcn_mfma_f32_32x32x16_bf16(ATT_VFRAG(2, 0), P0, O2, 0, 0, 0); O2 = __builtin_amdgcn_mfma_f32_32x32x16_bf16(ATT_VFRAG(2, 1), P1, O2, 0, 0, 0);
        O3 = __builtin_amdgcn_mfma_f32_32x32x16_bf16(ATT_VFRAG(3, 0), P0, O3, 0, 0, 0); O3 = __builtin_amdgcn_mfma_f32_32x32x16_bf16(ATT_VFRAG(3, 1), P1, O3, 0, 0, 0);
#undef ATT_VFRAG
        LDS_WAIT();
    }
#if ATT_LSUM_LATE
    lrun = X32SUM(lrun);
#endif
    const float inv = 1.0f / lrun;
    const unsigned wO = (unsigned)(KTP * rr + 8 * hh);
#pragma unroll
    for (int g = 0; g < 4; ++g) {
        v2u w;
        w.x = cvtpk(O0[4 * g] * inv, O0[4 * g + 1] * inv); w.y = cvtpk(O0[4 * g + 2] * inv, O0[4 * g + 3] * inv); *(LAS v2u*)(KB + wO + 16 * (0 + g)) = w;
        w.x = cvtpk(O1[4 * g] * inv, O1[4 * g + 1] * inv); w.y = cvtpk(O1[4 * g + 2] * inv, O1[4 * g + 3] * inv); *(LAS v2u*)(KB + wO + 16 * (4 + g)) = w;
        w.x = cvtpk(O2[4 * g] * inv, O2[4 * g + 1] * inv); w.y = cvtpk(O2[4 * g + 2] * inv, O2[4 * g + 3] * inv); *(LAS v2u*)(KB + wO + 16 * (8 + g)) = w;
        w.x = cvtpk(O3[4 * g] * inv, O3[4 * g + 1] * inv); w.y = cvtpk(O3[4 * g + 2] * inv, O3[4 * g + 3] * inv); *(LAS v2u*)(KB + wO + 16 * (12 + g)) = w;
    }
    LDS_WAIT();
#pragma unroll
    for (int i = 0; i < 8; ++i) { const v4u o = *(const LAS v4u*)(KB + wK + 4 * KTP * i); bstore(rsO, lO, hsO + (unsigned)(qtok0 + 4 * i * d) * opitch, o); }
    LDS_WAIT();
    if (MODE == 0 && hh == 0) ((GAS float*)LSE)[(((size_t)pat * NB + b) * NH + h) * S + r * (S / d) + 32 * qt + rr] = mrun + __builtin_amdgcn_logf(lrun);
}

struct P0Item { int k0, n0, nd0; };
__device__ __forceinline__ P0Item p0_decode(int N, int item, bool inperm) {
    const int nblk = N / 64, kb = item / nblk, nb = item - kb * nblk; P0Item t; t.k0 = 64 * kb; t.n0 = 64 * nb; t.nd0 = t.n0;
    if (inperm && t.n0 >= 6144 && t.n0 < 8192) { const int isg = t.n0 >= 7168, ch = t.n0 - (isg ? 7168 : 6144); t.nd0 = 6144 + 256 * (ch >> 7) + 128 * isg + (ch & 127); }
    return t;
}
__device__ __forceinline__ void p0_load(const float* W, int N, const P0Item& t, int lane, const float* gk, f32x4 (&v)[16], float (&gv)[16]) {
    const int kk = lane >> 4, c = lane & 15;
#pragma unroll
    for (int i = 0; i < 16; ++i) v[i] = *(const GAS f32x4*)(W + (size_t)(t.k0 + 4 * i + kk) * N + t.n0 + 4 * c);
    if (gk) {
#pragma unroll
        for (int i = 0; i < 16; ++i) gv[i] = ((const GAS float*)gk)[t.k0 + 4 * i + kk]; }
}
__device__ __forceinline__ void p0_finish(int K, bf16* WT, LAS unsigned char* scr, const P0Item& t, int lane, bool hasg, f32x4 (&v)[16], const float (&gv)[16]) {
    const int kk = lane >> 4, c = lane & 15;
    if (hasg) {
#pragma unroll
        for (int i = 0; i < 16; ++i) v[i] = v[i] * gv[i]; }
#pragma unroll
    for (int i = 0; i < 16; ++i) { v2u o; o.x = cvtpk(v[i].x, v[i].y); o.y = cvtpk(v[i].z, v[i].w); *(LAS v2u*)(scr + (4 * i + kk) * 160 + 8 * c) = o; }
    LDS_WAIT();
    const int g = lane >> 4, q = (lane & 15) >> 2, p = lane & 3, i16 = lane & 15, odd = g & 1;
#pragma unroll
    for (int nb4 = 0; nb4 < 4; ++nb4)
#pragma unroll
        for (int hs = 0; hs < 2; ++hs) { const int kc = 4 * hs + g; const int b0 = 2 * kc + odd, b1 = 2 * kc + 1 - odd;
            const s16x4v r0 = vtr(scr + (4 * b0 + q) * 160 + 32 * nb4 + 8 * p), r1 = vtr(scr + (4 * b1 + q) * 160 + 32 * nb4 + 8 * p);
            const s16x4v lo = odd ? r1 : r0, hi = odd ? r0 : r1;
            const bf16x8v o = {lo[0], lo[1], lo[2], lo[3], hi[0], hi[1], hi[2], hi[3]};
            *(GAS bf16x8v*)(WT + (size_t)(t.nd0 + 16 * nb4 + i16) * K + t.k0 + 8 * kc) = o; }
    LDS_WAIT();
}
__device__ __forceinline__ void p0_transpose_tile(const float* W, int K, int N, bf16* WT, LAS unsigned char* scr, int item, int lane, bool inperm, const float* gk  ) {
    const P0Item t = p0_decode(N, item, inperm); f32x4 v[16]; float gv[16];
    p0_load(W, N, t, lane, gk, v, gv); p0_finish(K, WT, scr, t, lane, gk != nullptr, v, gv);
}
__device__ __forceinline__ void p0_transpose_pair(const float* W, int K, int N, bf16* WT, LAS unsigned char* scr, int itemA, int itemB, int lane, bool inperm, const float* gk) {
    const P0Item ta = p0_decode(N, itemA, inperm), tb = p0_decode(N, itemB, inperm); f32x4 va[16], vb[16]; float ga[16], gb[16];
    p0_load(W, N, ta, lane, gk, va, ga); p0_load(W, N, tb, lane, gk, vb, gb);
    VM_WAIT();
    p0_finish(K, WT, scr, ta, lane, gk != nullptr, va, ga); p0_finish(K, WT, scr, tb, lane, gk != nullptr, vb, gb);
}

__device__ __forceinline__ void conv_finish(float (&acc)[16], int t, const float* lng, const float* lnb, const float* gmix, bf16* mixed, int c0) {
    float s = 0.f;
#pragma unroll
    for (int k = 0; k < 16; ++k) s += acc[k];
    const float mean = wave_sum(s) * (1.f / CONV_W); float q2 = 0.f;
#pragma unroll
    for (int k = 0; k < 16; ++k) { acc[k] -= mean; q2 += acc[k] * acc[k]; }
    const float rs = 1.0f / sqrtf(wave_sum(q2) * (1.f / CONV_W) + EPS); float s2 = 0.f;
#pragma unroll
    for (int q = 0; q < 4; ++q) { const f32x4 lg = *(const GAS f32x4*)(lng + c0 + 4 * q), lb = *(const GAS f32x4*)(lnb + c0 + 4 * q);
        float y;
        y = acc[4 * q + 0] * rs * lg.x + lb.x; acc[4 * q + 0] = y * sigm(y); y = acc[4 * q + 1] * rs * lg.y + lb.y; acc[4 * q + 1] = y * sigm(y);
        y = acc[4 * q + 2] * rs * lg.z + lb.z; acc[4 * q + 2] = y * sigm(y); y = acc[4 * q + 3] * rs * lg.w + lb.w; acc[4 * q + 3] = y * sigm(y); }
#pragma unroll
    for (int k = 0; k < 16; ++k) s2 += acc[k] * acc[k];
    const float r = 1.0f / sqrtf(wave_sum(s2) * (1.f / CONV_W) + EPS);
    unsigned ow[8];
#pragma unroll
    for (int q = 0; q < 4; ++q) { const f32x4 gm = *(const GAS f32x4*)(gmix + 2048 + c0 + 4 * q);
        ow[2 * q] = pk2(acc[4 * q] * r * gm.x, acc[4 * q + 1] * r * gm.y); ow[2 * q + 1] = pk2(acc[4 * q + 2] * r * gm.z, acc[4 * q + 3] * r * gm.w); }
    GAS v4u* op = (GAS v4u*)(mixed + (size_t)t * D + 2048 + c0);
    op[0] = (v4u){ow[0], ow[1], ow[2], ow[3]}; op[1] = (v4u){ow[4], ow[5], ow[6], ow[7]};
}

__device__ __forceinline__ void conv_naive_item(int t, const bf16* CH, const float* dw, const float* cb, const float* lng, const float* lnb, const float* gmix, bf16* mixed, int lane) {
    const int b = t >> 12, ts = t & (S - 1), c0 = 16 * lane;
    float acc[16];
#pragma unroll
    for (int q = 0; q < 4; ++q) { const f32x4 v = *(const GAS f32x4*)(cb + c0 + 4 * q); acc[4 * q] = v.x; acc[4 * q + 1] = v.y; acc[4 * q + 2] = v.z; acc[4 * q + 3] = v.w; }
    const int j0 = ts >= CONV_K - 1 ? 0 : CONV_K - 1 - ts;
#pragma unroll 4
    for (int j = j0; j < CONV_K; ++j) {
        const size_t ro = (size_t)(b * S + ts - (CONV_K - 1) + j) * 1024 + c0;
        const v4u a0 = *(const GAS v4u*)(CH + ro), a1 = *(const GAS v4u*)(CH + ro + 8);
        const unsigned aw[8] = {a0.x, a0.y, a0.z, a0.w, a1.x, a1.y, a1.z, a1.w};
        const GAS f32x4* w4 = (const GAS f32x4*)(dw + (size_t)j * CONV_W + c0);
#pragma unroll
        for (int q = 0; q < 4; ++q) { const f32x4 w = w4[q];
            acc[4 * q + 0] += w.x * blo(aw[2 * q]); acc[4 * q + 1] += w.y * bhi(aw[2 * q]); acc[4 * q + 2] += w.z * blo(aw[2 * q + 1]); acc[4 * q + 3] += w.w * bhi(aw[2 * q + 1]); }
    }
    conv_finish(acc, t, lng, lnb, gmix, mixed, c0);
}

__device__ __forceinline__ void conv_item4(int t0, const bf16* CH, const float* dw, const float* cb, const float* lng, const float* lnb, const float* gmix, bf16* mixed, int lane) {
    const int b = t0 >> 12, ts0 = t0 & (S - 1), c0 = 16 * lane;
    float acc[4][16];
#pragma unroll
    for (int q = 0; q < 4; ++q) { const f32x4 v = *(const GAS f32x4*)(cb + c0 + 4 * q);
#pragma unroll
        for (int k = 0; k < 4; ++k) { acc[k][4 * q] = v.x; acc[k][4 * q + 1] = v.y; acc[k][4 * q + 2] = v.z; acc[k][4 * q + 3] = v.w; } }
#pragma unroll 1
    for (int j = 0; j < CONV_K; ++j) {
        const GAS f32x4* w4 = (const GAS f32x4*)(dw + (size_t)j * CONV_W + c0);
        const f32x4 wa = w4[0], wb = w4[1], wc = w4[2], wd = w4[3];
#pragma unroll
        for (int k = 0; k < 4; ++k) { const int tt = ts0 + k - (CONV_K - 1) + j;
            if (tt >= 0) {
                const size_t ro = (size_t)(b * S + tt) * 1024 + c0;
                const v4u a0 = *(const GAS v4u*)(CH + ro), a1 = *(const GAS v4u*)(CH + ro + 8);
                acc[k][0] += wa.x * blo(a0.x); acc[k][1] += wa.y * bhi(a0.x); acc[k][2] += wa.z * blo(a0.y); acc[k][3] += wa.w * bhi(a0.y);
                acc[k][4] += wb.x * blo(a0.z); acc[k][5] += wb.y * bhi(a0.z); acc[k][6] += wb.z * blo(a0.w); acc[k][7] += wb.w * bhi(a0.w);
                acc[k][8] += wc.x * blo(a1.x); acc[k][9] += wc.y * bhi(a1.x); acc[k][10] += wc.z * blo(a1.y); acc[k][11] += wc.w * bhi(a1.y);
                acc[k][12] += wd.x * blo(a1.z); acc[k][13] += wd.y * bhi(a1.z); acc[k][14] += wd.z * blo(a1.w); acc[k][15] += wd.w * bhi(a1.w); } }
    }
#pragma unroll
    for (int k = 0; k < 4; ++k) conv_finish(acc[k], t0 + k, lng, lnb, gmix, mixed, c0);
}

__device__ __forceinline__ void conv_stage_weights(const float* dw, LAS unsigned char* lds, int tid) {
    for (int e = tid; e < CONV_K * CONV_W / 4; e += NWAVES * 64) { const int j = e >> 8, c4 = e & 255;
        *(LAS f32x4*)(lds + j * 4096 + (c4 & 3) * 1024 + (c4 >> 2) * 16) = *(const GAS f32x4*)(dw + (size_t)j * CONV_W + 4 * c4); }
}
__device__ __forceinline__ void conv_item4w(int t0, const bf16* CH, const LAS unsigned char* wl, const float* cb, const float* lng, const float* lnb, const float* gmix, bf16* mixed, int lane) {
    const int b = t0 >> 12, ts0 = t0 & (S - 1), c0 = 16 * lane;
    float acc[4][16];
#pragma unroll
    for (int q = 0; q < 4; ++q) { const f32x4 v = *(const GAS f32x4*)(cb + c0 + 4 * q);
#pragma unroll
        for (int k = 0; k < 4; ++k) { acc[k][4 * q] = v.x; acc[k][4 * q + 1] = v.y; acc[k][4 * q + 2] = v.z; acc[k][4 * q + 3] = v.w; } }
    const int rho0 = ts0 >= CONV_K - 1 ? 0 : CONV_K - 1 - ts0;
#pragma unroll 2
    for (int rho = rho0; rho < CONV_K + 3; ++rho) {
        const size_t ro = (size_t)(b * S + ts0 - (CONV_K - 1) + rho) * 1024 + c0;
        const v4u a0 = *(const GAS v4u*)(CH + ro), a1 = *(const GAS v4u*)(CH + ro + 8);
        const float h0 = blo(a0.x), h1 = bhi(a0.x), h2 = blo(a0.y), h3 = bhi(a0.y), h4 = blo(a0.z), h5 = bhi(a0.z), h6 = blo(a0.w), h7 = bhi(a0.w);
        const float h8 = blo(a1.x), h9 = bhi(a1.x), h10 = blo(a1.y), h11 = bhi(a1.y), h12 = blo(a1.z), h13 = bhi(a1.z), h14 = blo(a1.w), h15 = bhi(a1.w);
#pragma unroll
        for (int k = 0; k < 4; ++k) { const int j = rho - k;
            if ((unsigned)j < (unsigned)CONV_K) {
                const LAS f32x4* w4 = (const LAS f32x4*)(wl + j * 4096 + lane * 16);
                const f32x4 wa = w4[0], wb = w4[64], wc = w4[128], wd = w4[192];
                acc[k][0] += wa.x * h0; acc[k][1] += wa.y * h1; acc[k][2] += wa.z * h2; acc[k][3] += wa.w * h3;
                acc[k][4] += wb.x * h4; acc[k][5] += wb.y * h5; acc[k][6] += wb.z * h6; acc[k][7] += wb.w * h7;
                acc[k][8] += wc.x * h8; acc[k][9] += wc.y * h9; acc[k][10] += wc.z * h10; acc[k][11] += wc.w * h11;
                acc[k][12] += wd.x * h12; acc[k][13] += wd.y * h13; acc[k][14] += wd.z * h14; acc[k][15] += wd.w * h15; } }
    }
#pragma unroll
    for (int k = 0; k < 4; ++k) conv_finish(acc[k], t0 + k, lng, lnb, gmix, mixed, c0);
}

constexpr int CONV_RD = 4;
__device__ __forceinline__ void conv_item4p(int t0, const bf16* CH, const LAS unsigned char* wl, const float* cb, const float* lng, const float* lnb, const float* gmix, bf16* mixed, int lane) {
    const int b = t0 >> 12, ts0 = t0 & (S - 1), c0 = 16 * lane;
    float acc[4][16];
#pragma unroll
    for (int q = 0; q < 4; ++q) { const f32x4 v = *(const GAS f32x4*)(cb + c0 + 4 * q);
#pragma unroll
        for (int k = 0; k < 4; ++k) { acc[k][4 * q] = v.x; acc[k][4 * q + 1] = v.y; acc[k][4 * q + 2] = v.z; acc[k][4 * q + 3] = v.w; } }
    const int rho0 = ts0 >= CONV_K - 1 ? 0 : CONV_K - 1 - ts0;
    const bf16* base = CH + (size_t)(b * S) * 1024 + c0;
    v4u ra[CONV_RD], rb[CONV_RD]; f32x4 wt[4][4];
#pragma unroll
    for (int a = 0; a < 4; ++a)
#pragma unroll
        for (int q = 0; q < 4; ++q) wt[a][q] = (f32x4){0.f, 0.f, 0.f, 0.f};
#define CONV_LD(rho_, slot_) do { int rr_ = (rho_); rr_ = rr_ > CONV_K + 2 ? CONV_K + 2 : rr_; int tk_ = ts0 - (CONV_K - 1) + rr_; tk_ = tk_ < 0 ? 0 : tk_; \
        const GAS v4u* p_ = (const GAS v4u*)(base + (size_t)tk_ * 1024); ra[slot_] = p_[0]; rb[slot_] = p_[1]; } while (0)
#pragma unroll
    for (int i = 0; i < CONV_RD; ++i) CONV_LD(i, i);
#pragma unroll 1
    for (int r8 = 0; r8 < CONV_K + 3; r8 += CONV_RD) {
#pragma unroll
        for (int i = 0; i < CONV_RD; ++i) { const int rho = r8 + i;
            v4u a0 = ra[i], a1 = rb[i];
            CONV_LD(rho + CONV_RD, i);
            const unsigned mk = rho >= rho0 ? ~0u : 0u;
            a0.x &= mk; a0.y &= mk; a0.z &= mk; a0.w &= mk; a1.x &= mk; a1.y &= mk; a1.z &= mk; a1.w &= mk;
            const float h0 = blo(a0.x), h1 = bhi(a0.x), h2 = blo(a0.y), h3 = bhi(a0.y), h4 = blo(a0.z), h5 = bhi(a0.z), h6 = blo(a0.w), h7 = bhi(a0.w);
            const float h8 = blo(a1.x), h9 = bhi(a1.x), h10 = blo(a1.y), h11 = bhi(a1.y), h12 = blo(a1.z), h13 = bhi(a1.z), h14 = blo(a1.w), h15 = bhi(a1.w);
            {   const int jn = rho < CONV_K ? rho : CONV_K - 1;
                const LAS f32x4* w4 = (const LAS f32x4*)(wl + jn * 4096 + lane * 16);
                wt[i & 3][0] = w4[0]; wt[i & 3][1] = w4[64]; wt[i & 3][2] = w4[128]; wt[i & 3][3] = w4[192]; }
#pragma unroll
            for (int k = 0; k < 4; ++k) { const int j = rho - k;
                if ((unsigned)j < (unsigned)CONV_K) {
                    const f32x4 wa = wt[(i - k) & 3][0], wb = wt[(i - k) & 3][1], wc = wt[(i - k) & 3][2], wd = wt[(i - k) & 3][3];
                    acc[k][0] += wa.x * h0; acc[k][1] += wa.y * h1; acc[k][2] += wa.z * h2; acc[k][3] += wa.w * h3;
                    acc[k][4] += wb.x * h4; acc[k][5] += wb.y * h5; acc[k][6] += wb.z * h6; acc[k][7] += wb.w * h7;
                    acc[k][8] += wc.x * h8; acc[k][9] += wc.y * h9; acc[k][10] += wc.z * h10; acc[k][11] += wc.w * h11;
                    acc[k][12] += wd.x * h12; acc[k][13] += wd.y * h13; acc[k][14] += wd.z * h14; acc[k][15] += wd.w * h15; } } }
    }
#undef CONV_LD
#pragma unroll
    for (int k = 0; k < 4; ++k) conv_finish(acc[k], t0 + k, lng, lnb, gmix, mixed, c0);
}

__device__ __forceinline__ void sincos_small(float x, float& sn, float& cs) {
    const float k = rintf(x * 0.636619772367581343f);
    float r = fmaf(-k, 1.5703125f, x); r = fmaf(-k, 4.837512969970703125e-4f, r); r = fmaf(-k, 7.54978995489188216e-8f, r);
    const int q = (int)k & 3; const float r2 = r * r;
    const float sp = r + r * r2 * (-1.6666654611e-1f + r2 * (8.3321608736e-3f + r2 * (-1.9515295891e-4f)));
    const float cp = 1.0f + r2 * (-0.5f + r2 * (4.166664568298827e-2f + r2 * (-1.388731625493765e-3f + r2 * 2.443315711809948e-5f)));
    const float s0 = (q & 1) ? cp : sp, c0 = (q & 1) ? sp : cp;
    sn = (q & 2) ? -s0 : s0; cs = ((q + 1) & 2) ? -c0 : c0;
}
__device__ __forceinline__ float gelu_tanh(float y) { const float a = 0.7978845608028654f * (y + 0.044715f * y * y * y); const float e = __expf(2.f * a); const float th = 1.f - 2.f / (e + 1.f); return 0.5f * y * (1.f + th); }
template <bool PASS2> __device__ __forceinline__ void ssm_scan_chunk(const bf16* SU, bf16* Z, int b, int g, int wave, int lane, const float (&bbr)[16], const float (&bbi)[16], float lr, float li_, float& xr, float& xi,
                                                                    const float* dsk, LAS unsigned char* wl, const LAS float* Cs) {
    LAS v4u* Us4 = (LAS v4u*)wl;
    LAS float* Xs = (LAS float*)(wl + 512);
    const int tokl = lane >> 2, hq = lane & 3;
    const bf16* ubase = SU + (size_t)(b * S + 512 * wave + (lane >> 1)) * 1024 + 16 * g + 8 * (lane & 1);
    v4u unext = (v4u){0u, 0u, 0u, 0u};
    if (lane < 32) unext = *(const GAS v4u*)ubase;
    for (int kb = 0; kb < 32; ++kb) {
        const int tok0 = b * S + 512 * wave + 16 * kb;
        if (lane < 32) Us4[lane] = unext;
        if (lane < 32 && kb < 31) unext = *(const GAS v4u*)(ubase + (size_t)(kb + 1) * 16 * 1024);
        LDS_WAIT();
#pragma unroll 4
        for (int tk = 0; tk < 16; ++tk) {
            const v4u ua = Us4[2 * tk], ub = Us4[2 * tk + 1];
            const float u0 = blo(ua.x), u1 = bhi(ua.x), u2 = blo(ua.y), u3 = bhi(ua.y), u4 = blo(ua.z), u5 = bhi(ua.z), u6 = blo(ua.w), u7 = bhi(ua.w);
            const float u8 = blo(ub.x), u9 = bhi(ub.x), u10 = blo(ub.y), u11 = bhi(ub.y), u12 = blo(ub.z), u13 = bhi(ub.z), u14 = blo(ub.w), u15 = bhi(ub.w);
            const float bur = ((bbr[0] * u0 + bbr[1] * u1) + (bbr[2] * u2 + bbr[3] * u3)) + ((bbr[4] * u4 + bbr[5] * u5) + (bbr[6] * u6 + bbr[7] * u7)) +
                              ((bbr[8] * u8 + bbr[9] * u9) + (bbr[10] * u10 + bbr[11] * u11)) + ((bbr[12] * u12 + bbr[13] * u13) + (bbr[14] * u14 + bbr[15] * u15));
            const float bui = ((bbi[0] * u0 + bbi[1] * u1) + (bbi[2] * u2 + bbi[3] * u3)) + ((bbi[4] * u4 + bbi[5] * u5) + (bbi[6] * u6 + bbi[7] * u7)) +
                              ((bbi[8] * u8 + bbi[9] * u9) + (bbi[10] * u10 + bbi[11] * u11)) + ((bbi[12] * u12 + bbi[13] * u13) + (bbi[14] * u14 + bbi[15] * u15));
            const float nxr = lr * xr - li_ * xi + bur, nxi = lr * xi + li_ * xr + bui; xr = nxr; xi = nxi;
            if (PASS2) { Xs[lane * 17 + tk] = xr; Xs[1088 + lane * 17 + tk] = xi; }
        }
        if (PASS2) {
            LDS_WAIT();
            float y0 = 0.f, y1 = 0.f, y2 = 0.f, y3 = 0.f;
#pragma unroll 8
            for (int p = 0; p < 64; ++p) { const float xre = Xs[p * 17 + tokl], xim = Xs[1088 + p * 17 + tokl];
                const f32x4 cre = *(const LAS f32x4*)(Cs + p * 32 + 4 * hq), cim = *(const LAS f32x4*)(Cs + p * 32 + 16 + 4 * hq);
                y0 += cre.x * xre - cim.x * xim; y1 += cre.y * xre - cim.y * xim; y2 += cre.z * xre - cim.z * xim; y3 += cre.w * xre - cim.w * xim; }
            const v2u uu = *(const LAS v2u*)(wl + tokl * 32 + hq * 8);
            const f32x4 dk = *(const GAS f32x4*)(dsk + 16 * g + 4 * hq);
            y0 += dk.x * blo(uu.x); y1 += dk.y * bhi(uu.x); y2 += dk.z * blo(uu.y); y3 += dk.w * bhi(uu.y);
            v2u o; o.x = pk2(gelu_tanh(y0), gelu_tanh(y1)); o.y = pk2(gelu_tanh(y2), gelu_tanh(y3));
            *(GAS v2u*)(Z + (size_t)(tok0 + tokl) * 1024 + 16 * g + 4 * hq) = o;
        }
        LDS_WAIT();
    }
}
__device__ __forceinline__ void ssm_unit(int unit, int l, const float* a_re, const float* a_im, const float* b_re, const float* b_im, const float* c_re, const float* c_im, const float* dsk, const float* log_step,
                                         const bf16* SU, bf16* Z, LAS unsigned char* lds, int tid, int wave, int lane) {
    const int b = unit >> 6, g = unit & 63, lg = l * SSM_G + g;
    LAS float* Cs = (LAS float*)lds;
    LAS float* Es = (LAS float*)(lds + 8192);
    LAS unsigned char* wl = lds + 16384 + wave * 12288;
    for (int e = tid; e < 1024; e += NWAVES * 64) { const int p = e >> 4, h = e & 15; Cs[p * 32 + h] = ((const GAS float*)c_re)[((size_t)lg * 16 + h) * 64 + p]; Cs[p * 32 + 16 + h] = ((const GAS float*)c_im)[((size_t)lg * 16 + h) * 64 + p]; }
    const float are = ((const GAS float*)a_re)[lg * 64 + lane], aim = ((const GAS float*)a_im)[lg * 64 + lane], step = expf(((const GAS float*)log_step)[lg]);
    float sn, cs; sincos_small(aim * step, sn, cs);
    const float er = expf(are * step), lr = er * cs, li_ = er * sn;
    const float den = 1.0f / (are * are + aim * aim), nr = lr - 1.0f, cr = (nr * are + li_ * aim) * den, ci = (li_ * are - nr * aim) * den;
    float bbr[16], bbi[16];
#pragma unroll
    for (int q = 0; q < 4; ++q) { const f32x4 br = *(const GAS f32x4*)(b_re + ((size_t)lg * 64 + lane) * 16 + 4 * q), bi = *(const GAS f32x4*)(b_im + ((size_t)lg * 64 + lane) * 16 + 4 * q);
        bbr[4 * q + 0] = cr * br.x - ci * bi.x; bbi[4 * q + 0] = cr * bi.x + ci * br.x; bbr[4 * q + 1] = cr * br.y - ci * bi.y; bbi[4 * q + 1] = cr * bi.y + ci * br.y;
        bbr[4 * q + 2] = cr * br.z - ci * bi.z; bbi[4 * q + 2] = cr * bi.z + ci * br.z; bbr[4 * q + 3] = cr * br.w - ci * bi.w; bbi[4 * q + 3] = cr * bi.w + ci * br.w; }
    float Lr = lr, Li = li_;
#pragma unroll
    for (int q = 0; q < 9; ++q) { const float t0 = Lr * Lr - Li * Li, t1 = 2.f * Lr * Li; Lr = t0; Li = t1; }
    float xr = 0.f, xi = 0.f;
    ssm_scan_chunk<false>(SU, Z, b, g, wave, lane, bbr, bbi, lr, li_, xr, xi, dsk, wl, Cs);
    Es[(wave * 64 + lane) * 2] = xr; Es[(wave * 64 + lane) * 2 + 1] = xi;
    LDS_WAIT(); __syncthreads();
    xr = 0.f; xi = 0.f;
    for (int c = 0; c < wave; ++c) { const float er_ = Es[(c * 64 + lane) * 2], ei_ = Es[(c * 64 + lane) * 2 + 1]; const float t0 = Lr * xr - Li * xi + er_, t1 = Lr * xi + Li * xr + ei_; xr = t0; xi = t1; }
    ssm_scan_chunk<true>(SU, Z, b, g, wave, lane, bbr, bbi, lr, li_, xr, xi, dsk, wl, Cs);
    LDS_WAIT(); __syncthreads();
}

__device__ __forceinline__ f32x16 zero16() { f32x16 z;
#pragma unroll
    for (int i = 0; i < 16; ++i) z[i] = 0.f; return z; }
template <bool PASS2> __device__ __forceinline__ void ssm_mfma_pass(const bf16* SU, bf16* Z, int b, int g, int wave, int lane, bf16x8v Bre0, bf16x8v Bre1, bf16x8v Bim0, bf16x8v Bim1,
                                                                   const bf16x8v (&Cf)[8], bf16x8v Df, float lr0, float li0, float lr1, float li1, float& x0r, float& x0i, float& x1r, float& x1i, LAS unsigned char* img) {
    const int c = lane & 31, hh = lane >> 5;
    const int strm = (c >> 2) & 1, idx = 4 * (c >> 3) + (c & 3);
    const bf16* up = SU + (size_t)(b * S + (2 * wave + strm) * 256 + idx) * 1024 + 16 * g + 8 * hh;
    const int q = (lane & 15) >> 2, p = lane & 3, blk = (lane >> 4) & 1;
    v4u unext = *(const GAS v4u*)up;
    for (int tile = 0; tile < 16; ++tile) {
        const bf16x8v Uf = __builtin_bit_cast(bf16x8v, unext);
        if (tile < 15) unext = *(const GAS v4u*)(up + (size_t)(tile + 1) * 16 * 1024);
        f32x16 are0 = __builtin_amdgcn_mfma_f32_32x32x16_bf16(Uf, Bre0, zero16(), 0, 0, 0), aim0 = __builtin_amdgcn_mfma_f32_32x32x16_bf16(Uf, Bim0, zero16(), 0, 0, 0);
        f32x16 are1 = __builtin_amdgcn_mfma_f32_32x32x16_bf16(Uf, Bre1, zero16(), 0, 0, 0), aim1 = __builtin_amdgcn_mfma_f32_32x32x16_bf16(Uf, Bim1, zero16(), 0, 0, 0);
#pragma unroll
        for (int r = 0; r < 16; ++r) {
            const float n0r = lr0 * x0r - li0 * x0i + are0[r], n0i = lr0 * x0i + li0 * x0r + aim0[r]; x0r = n0r; x0i = n0i;
            const float n1r = lr1 * x1r - li1 * x1i + are1[r], n1i = lr1 * x1i + li1 * x1r + aim1[r]; x1r = n1r; x1i = n1i;
            if (PASS2) { are0[r] = x0r; aim0[r] = x0i; are1[r] = x1r; aim1[r] = x1i; }
        }
        if (PASS2) {
#pragma unroll
            for (int gq = 0; gq < 4; ++gq) { v2u w; const int o = c * 64 + 8 * (2 * gq + hh);
                w.x = cvtpk(are0[4 * gq], are0[4 * gq + 1]); w.y = cvtpk(are0[4 * gq + 2], are0[4 * gq + 3]); *(LAS v2u*)(img + 0 * 2048 + o) = w;
                w.x = cvtpk(are1[4 * gq], are1[4 * gq + 1]); w.y = cvtpk(are1[4 * gq + 2], are1[4 * gq + 3]); *(LAS v2u*)(img + 1 * 2048 + o) = w;
                w.x = cvtpk(aim0[4 * gq], aim0[4 * gq + 1]); w.y = cvtpk(aim0[4 * gq + 2], aim0[4 * gq + 3]); *(LAS v2u*)(img + 2 * 2048 + o) = w;
                w.x = cvtpk(aim1[4 * gq], aim1[4 * gq + 1]); w.y = cvtpk(aim1[4 * gq + 2], aim1[4 * gq + 3]); *(LAS v2u*)(img + 3 * 2048 + o) = w; }
            LDS_WAIT();
            f32x16 y = __builtin_amdgcn_mfma_f32_32x32x16_bf16(Uf, Df, zero16(), 0, 0, 0);
#pragma unroll
            for (int T = 0; T < 4; ++T)
#pragma unroll
                for (int s = 0; s < 2; ++s) { const LAS unsigned char* a = img + T * 2048 + (16 * s + 8 * hh + q) * 64 + 8 * (4 * blk + p);
                    const s16x4v lo = vtr(a), hi = vtr(a + 4 * 64);
                    const bf16x8v xa = {lo[0], lo[1], lo[2], lo[3], hi[0], hi[1], hi[2], hi[3]};
                    y = __builtin_amdgcn_mfma_f32_32x32x16_bf16(xa, Cf[2 * T + s], y, 0, 0, 0); }
            {
                LDS_WAIT();
                LAS bf16* zt = (LAS bf16*)img;
                if (c < 16) {
#pragma unroll
                    for (int r = 0; r < 16; ++r) zt[(hh * 16 + r) * 16 + c] = (bf16)f2bf(gelu_tanh(y[r])); }
                LDS_WAIT();
                const int ti = lane >> 1, hf = lane & 1;
                const v4u zv = *(const LAS v4u*)(img + ti * 32 + hf * 16);
                *(GAS v4u*)(Z + (size_t)(b * S + (2 * wave + (ti >> 4)) * 256 + 16 * tile + (ti & 15)) * 1024 + 16 * g + 8 * hf) = zv;
            }
            LDS_WAIT();
        }
    }
}
__device__ __forceinline__ bf16x8v pack8(const float (&v)[8]) { v4u w; w.x = cvtpk(v[0], v[1]); w.y = cvtpk(v[2], v[3]); w.z = cvtpk(v[4], v[5]); w.w = cvtpk(v[6], v[7]); return __builtin_bit_cast(bf16x8v, w); }
__device__ __forceinline__ void ssm_disc(const float* a_re, const float* a_im, int lg, int pst, float step, float& lr, float& li_, float& cr, float& ci) {
    const float are = ((const GAS float*)a_re)[lg * 64 + pst], aim = ((const GAS float*)a_im)[lg * 64 + pst]; float sn, cs; sincos_small(aim * step, sn, cs);
    const float er = expf(are * step); lr = er * cs; li_ = er * sn;
    const float den = 1.0f / (are * are + aim * aim), nr = lr - 1.0f; cr = (nr * are + li_ * aim) * den; ci = (li_ * are - nr * aim) * den;
}
__device__ __forceinline__ void ssm_unit_mfma(int unit, int l, const float* a_re, const float* a_im, const float* b_re, const float* b_im, const float* c_re, const float* c_im, const float* dsk, const float* log_step,
                                              const bf16* SU, bf16* Z, LAS unsigned char* lds, int wave, int lane) {
    const int b = unit >> 6, g = unit & 63, lg = l * SSM_G + g;
    const int c = lane & 31, hh = lane >> 5;
    LAS float* Es = (LAS float*)lds;
    LAS unsigned char* img = lds + 8192 + wave * 8192;
    const float step = expf(((const GAS float*)log_step)[lg]);
    float lr0, li0, cr0, ci0, lr1, li1, cr1, ci1;
    ssm_disc(a_re, a_im, lg, c, step, lr0, li0, cr0, ci0); ssm_disc(a_re, a_im, lg, c + 32, step, lr1, li1, cr1, ci1);
    bf16x8v Bre0, Bre1, Bim0, Bim1;
    {   float vr[8], vi[8];
        const GAS f32x4* br = (const GAS f32x4*)(b_re + ((size_t)lg * 64 + c) * 16 + 8 * hh); const GAS f32x4* bi = (const GAS f32x4*)(b_im + ((size_t)lg * 64 + c) * 16 + 8 * hh);
        f32x4 r0 = br[0], r1 = br[1], i0 = bi[0], i1 = bi[1];
        float rr_[8] = {r0.x, r0.y, r0.z, r0.w, r1.x, r1.y, r1.z, r1.w}, ii_[8] = {i0.x, i0.y, i0.z, i0.w, i1.x, i1.y, i1.z, i1.w};
#pragma unroll
        for (int j = 0; j < 8; ++j) { vr[j] = cr0 * rr_[j] - ci0 * ii_[j]; vi[j] = cr0 * ii_[j] + ci0 * rr_[j]; }
        Bre0 = pack8(vr); Bim0 = pack8(vi);
        br += 32 * 4; bi += 32 * 4;
        r0 = br[0]; r1 = br[1]; i0 = bi[0]; i1 = bi[1];
        float rr2[8] = {r0.x, r0.y, r0.z, r0.w, r1.x, r1.y, r1.z, r1.w}, ii2[8] = {i0.x, i0.y, i0.z, i0.w, i1.x, i1.y, i1.z, i1.w};
#pragma unroll
        for (int j = 0; j < 8; ++j) { vr[j] = cr1 * rr2[j] - ci1 * ii2[j]; vi[j] = cr1 * ii2[j] + ci1 * rr2[j]; }
        Bre1 = pack8(vr); Bim1 = pack8(vi);
    }
    bf16x8v Cf[8], Df;
    {   const int hc = c & 15; const float msk = c < 16 ? 1.f : 0.f;
#pragma unroll
        for (int T = 0; T < 4; ++T)
#pragma unroll
            for (int s = 0; s < 2; ++s) { const float* src = (T < 2 ? c_re : c_im) + ((size_t)lg * 16 + hc) * 64 + 32 * (T & 1) + 16 * s + 8 * hh;
                const f32x4 a = *(const GAS f32x4*)src, bq = *(const GAS f32x4*)(src + 4); const float sg = (T < 2 ? msk : -msk);
                float v[8] = {a.x * sg, a.y * sg, a.z * sg, a.w * sg, bq.x * sg, bq.y * sg, bq.z * sg, bq.w * sg}; Cf[2 * T + s] = pack8(v); }
        const float dv = ((const GAS float*)dsk)[16 * g + hc] * msk; float v[8];
#pragma unroll
        for (int j = 0; j < 8; ++j) v[j] = (8 * hh + j == c) ? dv : 0.f;
        Df = pack8(v);
    }
    float L0r = lr0, L0i = li0, L1r = lr1, L1i = li1;
#pragma unroll
    for (int k = 0; k < 8; ++k) { float t0 = L0r * L0r - L0i * L0i, t1 = 2.f * L0r * L0i; L0r = t0; L0i = t1; t0 = L1r * L1r - L1i * L1i; t1 = 2.f * L1r * L1i; L1r = t0; L1i = t1; }
    float x0r = 0.f, x0i = 0.f, x1r = 0.f, x1i = 0.f;
    ssm_mfma_pass<false>(SU, Z, b, g, wave, lane, Bre0, Bre1, Bim0, Bim1, Cf, Df, lr0, li0, lr1, li1, x0r, x0i, x1r, x1i, img);
    { const int ch = 2 * wave + hh; Es[(ch * 64 + c) * 2] = x0r; Es[(ch * 64 + c) * 2 + 1] = x0i; Es[(ch * 64 + c + 32) * 2] = x1r; Es[(ch * 64 + c + 32) * 2 + 1] = x1i; }
    LDS_WAIT(); __syncthreads();
    x0r = 0.f; x0i = 0.f; x1r = 0.f; x1i = 0.f;
    { const int ch = 2 * wave + hh;
      for (int cc = 0; cc < ch; ++cc) { const float e0r = Es[(cc * 64 + c) * 2], e0i = Es[(cc * 64 + c) * 2 + 1], e1r = Es[(cc * 64 + c + 32) * 2], e1i = Es[(cc * 64 + c + 32) * 2 + 1];
          float t0 = L0r * x0r - L0i * x0i + e0r, t1 = L0r * x0i + L0i * x0r + e0i; x0r = t0; x0i = t1; t0 = L1r * x1r - L1i * x1i + e1r; t1 = L1r * x1i + L1i * x1r + e1i; x1r = t0; x1i = t1; } }
    ssm_mfma_pass<true>(SU, Z, b, g, wave, lane, Bre0, Bre1, Bim0, Bim1, Cf, Df, lr0, li0, lr1, li1, x0r, x0i, x1r, x1i, img);
    LDS_WAIT(); __syncthreads();
}

__device__ __forceinline__ void ssm_unit_hybrid(int unit, int l, const float* a_re, const float* a_im, const float* b_re, const float* b_im, const float* c_re, const float* c_im, const float* dsk, const float* log_step,
                                                const bf16* SU, bf16* Z, LAS unsigned char* lds, int tid, int wave, int lane) {
    const int b = unit >> 6, g = unit & 63, lg = l * SSM_G + g;
    LAS float* Cs = (LAS float*)lds;
    LAS float* Es = (LAS float*)(lds + 8192);
    LAS unsigned char* wl = lds + 16384 + wave * 12288;
    for (int e = tid; e < 1024; e += NWAVES * 64) { const int p = e >> 4, h = e & 15; Cs[p * 32 + h] = ((const GAS float*)c_re)[((size_t)lg * 16 + h) * 64 + p]; Cs[p * 32 + 16 + h] = ((const GAS float*)c_im)[((size_t)lg * 16 + h) * 64 + p]; }
    const float step = expf(((const GAS float*)log_step)[lg]);
    {
        const int c = lane & 31, hh = lane >> 5;
        float lr0, li0, cr0, ci0, lr1, li1, cr1, ci1;
        ssm_disc(a_re, a_im, lg, c, step, lr0, li0, cr0, ci0); ssm_disc(a_re, a_im, lg, c + 32, step, lr1, li1, cr1, ci1);
        bf16x8v Bre0, Bre1, Bim0, Bim1;
        {   float vr[8], vi[8];
            const GAS f32x4* br = (const GAS f32x4*)(b_re + ((size_t)lg * 64 + c) * 16 + 8 * hh); const GAS f32x4* bi = (const GAS f32x4*)(b_im + ((size_t)lg * 64 + c) * 16 + 8 * hh);
            f32x4 r0 = br[0], r1 = br[1], i0 = bi[0], i1 = bi[1];
            float rr_[8] = {r0.x, r0.y, r0.z, r0.w, r1.x, r1.y, r1.z, r1.w}, ii_[8] = {i0.x, i0.y, i0.z, i0.w, i1.x, i1.y, i1.z, i1.w};
#pragma unroll
            for (int j = 0; j < 8; ++j) { vr[j] = cr0 * rr_[j] - ci0 * ii_[j]; vi[j] = cr0 * ii_[j] + ci0 * rr_[j]; }
            Bre0 = pack8(vr); Bim0 = pack8(vi);
            br += 32 * 4; bi += 32 * 4;
            r0 = br[0]; r1 = br[1]; i0 = bi[0]; i1 = bi[1];
            float rr2[8] = {r0.x, r0.y, r0.z, r0.w, r1.x, r1.y, r1.z, r1.w}, ii2[8] = {i0.x, i0.y, i0.z, i0.w, i1.x, i1.y, i1.z, i1.w};
#pragma unroll
            for (int j = 0; j < 8; ++j) { vr[j] = cr1 * rr2[j] - ci1 * ii2[j]; vi[j] = cr1 * ii2[j] + ci1 * rr2[j]; }
            Bre1 = pack8(vr); Bim1 = pack8(vi);
        }
        bf16x8v Cdummy[8];
#pragma unroll
        for (int q = 0; q < 8; ++q) Cdummy[q] = Bre0;
        float x0r = 0.f, x0i = 0.f, x1r = 0.f, x1i = 0.f;
        ssm_mfma_pass<false>(SU, Z, b, g, wave, lane, Bre0, Bre1, Bim0, Bim1, Cdummy, Bre0, lr0, li0, lr1, li1, x0r, x0i, x1r, x1i, wl);
        const int ch = 2 * wave + hh; Es[(ch * 64 + c) * 2] = x0r; Es[(ch * 64 + c) * 2 + 1] = x0i; Es[(ch * 64 + c + 32) * 2] = x1r; Es[(ch * 64 + c + 32) * 2 + 1] = x1i;
    }
    float lr, li_, cr, ci; ssm_disc(a_re, a_im, lg, lane, step, lr, li_, cr, ci);
    float bbr[16], bbi[16];
#pragma unroll
    for (int q = 0; q < 4; ++q) { const f32x4 br = *(const GAS f32x4*)(b_re + ((size_t)lg * 64 + lane) * 16 + 4 * q), bi = *(const GAS f32x4*)(b_im + ((size_t)lg * 64 + lane) * 16 + 4 * q);
        bbr[4 * q + 0] = cr * br.x - ci * bi.x; bbi[4 * q + 0] = cr * bi.x + ci * br.x; bbr[4 * q + 1] = cr * br.y - ci * bi.y; bbi[4 * q + 1] = cr * bi.y + ci * br.y;
        bbr[4 * q + 2] = cr * br.z - ci * bi.z; bbi[4 * q + 2] = cr * bi.z + ci * br.z; bbr[4 * q + 3] = cr * br.w - ci * bi.w; bbi[4 * q + 3] = cr * bi.w + ci * br.w; }
    float Lr = lr, Li = li_;
#pragma unroll
    for (int q = 0; q < 8; ++q) { const float t0 = Lr * Lr - Li * Li, t1 = 2.f * Lr * Li; Lr = t0; Li = t1; }
    LDS_WAIT(); __syncthreads();
    float xr = 0.f, xi = 0.f;
    for (int cc = 0; cc < 2 * wave; ++cc) { const float er_ = Es[(cc * 64 + lane) * 2], ei_ = Es[(cc * 64 + lane) * 2 + 1]; const float t0 = Lr * xr - Li * xi + er_, t1 = Lr * xi + Li * xr + ei_; xr = t0; xi = t1; }
    ssm_scan_chunk<true>(SU, Z, b, g, wave, lane, bbr, bbi, lr, li_, xr, xi, dsk, wl, Cs);
    LDS_WAIT(); __syncthreads();
}

__device__ __forceinline__ void post_item(int t, const bf16* PART, const float* LSE, const bf16* SG, const float* gmix, bf16* mixed, int lane) {
    {
        const int hd = lane >> 2;
        const int b_ = t >> 12, ts_ = t & (S - 1);
        const GAS float* LSEg = (const GAS float*)LSE;
        const float L0 = LSEg[(((size_t)0 * NB + b_) * NH + hd) * S + ts_], L1 = LSEg[(((size_t)1 * NB + b_) * NH + hd) * S + (ts_ & 3) * (S / 4) + (ts_ >> 2)], L2 = LSEg[(((size_t)2 * NB + b_) * NH + hd) * S + (ts_ & 15) * (S / 16) + (ts_ >> 4)];
        const float mx = fmaxf(L0, fmaxf(L1, L2)); float w0 = __builtin_amdgcn_exp2f(L0 - mx), w1 = __builtin_amdgcn_exp2f(L1 - mx), w2 = __builtin_amdgcn_exp2f(L2 - mx);
        const float wi = 1.0f / (w0 + w1 + w2); w0 *= wi; w1 *= wi; w2 *= wi;
        const GAS v4u* p0 = (const GAS v4u*)(PART + (size_t)t * ATTN_W + 32 * lane); const GAS v4u* p1 = (const GAS v4u*)(PART + (size_t)M * ATTN_W + (size_t)t * ATTN_W + 32 * lane);
        const GAS v4u* p2 = (const GAS v4u*)(PART + (size_t)2 * M * ATTN_W + (size_t)t * ATTN_W + 32 * lane);
        float mv[32]; float s = 0.f;
#pragma unroll
        for (int q = 0; q < 4; ++q) { const v4u a = p0[q], b = p1[q], c = p2[q];
            mv[8 * q + 0] = w0 * blo(a.x) + w1 * blo(b.x) + w2 * blo(c.x); mv[8 * q + 1] = w0 * bhi(a.x) + w1 * bhi(b.x) + w2 * bhi(c.x);
            mv[8 * q + 2] = w0 * blo(a.y) + w1 * blo(b.y) + w2 * blo(c.y); mv[8 * q + 3] = w0 * bhi(a.y) + w1 * bhi(b.y) + w2 * bhi(c.y);
            mv[8 * q + 4] = w0 * blo(a.z) + w1 * blo(b.z) + w2 * blo(c.z); mv[8 * q + 5] = w0 * bhi(a.z) + w1 * bhi(b.z) + w2 * bhi(c.z);
            mv[8 * q + 6] = w0 * blo(a.w) + w1 * blo(b.w) + w2 * blo(c.w); mv[8 * q + 7] = w0 * bhi(a.w) + w1 * bhi(b.w) + w2 * bhi(c.w); }
#pragma unroll
        for (int k = 0; k < 32; ++k) s += mv[k] * mv[k];
        const float r = 1.0f / sqrtf(wave_sum(s) * (1.f / ATTN_W) + EPS);
        GAS v4u* op = (GAS v4u*)(mixed + (size_t)t * D + 32 * lane);
#pragma unroll
        for (int q = 0; q < 4; ++q) { const f32x4 g0 = *(const GAS f32x4*)(gmix + 32 * lane + 8 * q), g1 = *(const GAS f32x4*)(gmix + 32 * lane + 8 * q + 4);
            v4u o; o.x = pk2(mv[8 * q] * r * g0.x, mv[8 * q + 1] * r * g0.y); o.y = pk2(mv[8 * q + 2] * r * g0.z, mv[8 * q + 3] * r * g0.w);
            o.z = pk2(mv[8 * q + 4] * r * g1.x, mv[8 * q + 5] * r * g1.y); o.w = pk2(mv[8 * q + 6] * r * g1.z, mv[8 * q + 7] * r * g1.w); op[q] = o; }
    }
    {   const GAS v4u* sp = (const GAS v4u*)(SG + (size_t)t * SSM_W + 16 * lane); v4u a[2]; float s = 0.f;
#pragma unroll
        for (int q = 0; q < 2; ++q) { a[q] = sp[q]; const float e0 = blo(a[q].x), e1 = bhi(a[q].x), e2 = blo(a[q].y), e3 = bhi(a[q].y), e4 = blo(a[q].z), e5 = bhi(a[q].z), e6 = blo(a[q].w), e7 = bhi(a[q].w);
            s += (e0 * e0 + e1 * e1) + (e2 * e2 + e3 * e3) + (e4 * e4 + e5 * e5) + (e6 * e6 + e7 * e7); }
        const float r = 1.0f / sqrtf(wave_sum(s) * (1.f / SSM_W) + EPS);
        GAS v4u* op = (GAS v4u*)(mixed + (size_t)t * D + 3072 + 16 * lane);
#pragma unroll
        for (int q = 0; q < 2; ++q) { const f32x4 g0 = *(const GAS f32x4*)(gmix + 3072 + 16 * lane + 8 * q), g1 = *(const GAS f32x4*)(gmix + 3072 + 16 * lane + 8 * q + 4);
            v4u o; o.x = pk2(blo(a[q].x) * r * g0.x, bhi(a[q].x) * r * g0.y); o.y = pk2(blo(a[q].y) * r * g0.z, bhi(a[q].y) * r * g0.w);
            o.z = pk2(blo(a[q].z) * r * g1.x, bhi(a[q].z) * r * g1.y); o.w = pk2(blo(a[q].w) * r * g1.z, bhi(a[q].w) * r * g1.w); op[q] = o; }
    }
}

__device__ __forceinline__ void post_item2(int ta, int tb, const bf16* PART, const float* LSE, const bf16* SG, const float* gmix, bf16* mixed, int lane) {
    const int hd = lane >> 2; const GAS float* LSEg = (const GAS float*)LSE;
    float L[2][3]; v4u pa[2][3][4]; v4u sa[2][2];
#pragma unroll
    for (int u = 0; u < 2; ++u) { const int t = u ? tb : ta; const int b_ = t >> 12, ts_ = t & (S - 1);
        L[u][0] = LSEg[(((size_t)0 * NB + b_) * NH + hd) * S + ts_]; L[u][1] = LSEg[(((size_t)1 * NB + b_) * NH + hd) * S + (ts_ & 3) * (S / 4) + (ts_ >> 2)];
        L[u][2] = LSEg[(((size_t)2 * NB + b_) * NH + hd) * S + (ts_ & 15) * (S / 16) + (ts_ >> 4)];
#pragma unroll
        for (int pp = 0; pp < 3; ++pp) { const GAS v4u* p = (const GAS v4u*)(PART + (size_t)pp * M * ATTN_W + (size_t)t * ATTN_W + 32 * lane);
#pragma unroll
            for (int q = 0; q < 4; ++q) pa[u][pp][q] = p[q]; }
        const GAS v4u* sp = (const GAS v4u*)(SG + (size_t)t * SSM_W + 16 * lane); sa[u][0] = sp[0]; sa[u][1] = sp[1]; }
    VM_WAIT();
#pragma unroll
    for (int u = 0; u < 2; ++u) { const int t = u ? tb : ta;
        {   const float L0 = L[u][0], L1 = L[u][1], L2 = L[u][2];
            const float mx = fmaxf(L0, fmaxf(L1, L2)); float w0 = __builtin_amdgcn_exp2f(L0 - mx), w1 = __builtin_amdgcn_exp2f(L1 - mx), w2 = __builtin_amdgcn_exp2f(L2 - mx);
            const float wi = 1.0f / (w0 + w1 + w2); w0 *= wi; w1 *= wi; w2 *= wi;
            float mv[32]; float s = 0.f;
#pragma unroll
            for (int q = 0; q < 4; ++q) { const v4u a = pa[u][0][q], b = pa[u][1][q], c = pa[u][2][q];
                mv[8 * q + 0] = w0 * blo(a.x) + w1 * blo(b.x) + w2 * blo(c.x); mv[8 * q + 1] = w0 * bhi(a.x) + w1 * bhi(b.x) + w2 * bhi(c.x);
                mv[8 * q + 2] = w0 * blo(a.y) + w1 * blo(b.y) + w2 * blo(c.y); mv[8 * q + 3] = w0 * bhi(a.y) + w1 * bhi(b.y) + w2 * bhi(c.y);
                mv[8 * q + 4] = w0 * blo(a.z) + w1 * blo(b.z) + w2 * blo(c.z); mv[8 * q + 5] = w0 * bhi(a.z) + w1 * bhi(b.z) + w2 * bhi(c.z);
                mv[8 * q + 6] = w0 * blo(a.w) + w1 * blo(b.w) + w2 * blo(c.w); mv[8 * q + 7] = w0 * bhi(a.w) + w1 * bhi(b.w) + w2 * bhi(c.w); }
#pragma unroll
            for (int k = 0; k < 32; ++k) s += mv[k] * mv[k];
            const float r = 1.0f / sqrtf(wave_sum(s) * (1.f / ATTN_W) + EPS);
            GAS v4u* op = (GAS v4u*)(mixed + (size_t)t * D + 32 * lane);
#pragma unroll
            for (int q = 0; q < 4; ++q) { const f32x4 g0 = *(const GAS f32x4*)(gmix + 32 * lane + 8 * q), g1 = *(const GAS f32x4*)(gmix + 32 * lane + 8 * q + 4);
                v4u o; o.x = pk2(mv[8 * q] * r * g0.x, mv[8 * q + 1] * r * g0.y); o.y = pk2(mv[8 * q + 2] * r * g0.z, mv[8 * q + 3] * r * g0.w);
                o.z = pk2(mv[8 * q + 4] * r * g1.x, mv[8 * q + 5] * r * g1.y); o.w = pk2(mv[8 * q + 6] * r * g1.z, mv[8 * q + 7] * r * g1.w); op[q] = o; }
        }
        {   float s = 0.f;
#pragma unroll
            for (int q = 0; q < 2; ++q) { const v4u a = sa[u][q]; const float e0 = blo(a.x), e1 = bhi(a.x), e2 = blo(a.y), e3 = bhi(a.y), e4 = blo(a.z), e5 = bhi(a.z), e6 = blo(a.w), e7 = bhi(a.w);
                s += (e0 * e0 + e1 * e1) + (e2 * e2 + e3 * e3) + (e4 * e4 + e5 * e5) + (e6 * e6 + e7 * e7); }
            const float r = 1.0f / sqrtf(wave_sum(s) * (1.f / SSM_W) + EPS);
            GAS v4u* op = (GAS v4u*)(mixed + (size_t)t * D + 3072 + 16 * lane);
#pragma unroll
            for (int q = 0; q < 2; ++q) { const v4u a = sa[u][q]; const f32x4 g0 = *(const GAS f32x4*)(gmix + 3072 + 16 * lane + 8 * q), g1 = *(const GAS f32x4*)(gmix + 3072 + 16 * lane + 8 * q + 4);
                v4u o; o.x = pk2(blo(a.x) * r * g0.x, bhi(a.x) * r * g0.y); o.y = pk2(blo(a.y) * r * g0.z, bhi(a.y) * r * g0.w);
                o.z = pk2(blo(a.z) * r * g1.x, bhi(a.z) * r * g1.y); o.w = pk2(blo(a.w) * r * g1.z, bhi(a.w) * r * g1.w); op[q] = o; }
        }
    }
}

struct Args { const float* in[32]; float* out; unsigned char* ws; int ph_lo, ph_hi; };
constexpr int PT_OFF = LDSCTL_OFF + 1024;
__device__ __forceinline__ const float* pt_get(volatile LAS unsigned* PT, int i) {
    unsigned a = PT[2 * i], b = PT[2 * i + 1];
    a = __builtin_amdgcn_readfirstlane(a); b = __builtin_amdgcn_readfirstlane(b);
    return (const float*)(((unsigned long long)b << 32) | (unsigned long long)a);
}
__global__ void __launch_bounds__(NWAVES * 64, 2) fwd(Args args) {
    extern __shared__ __attribute__((aligned(16))) unsigned char lds_raw[];
    LAS unsigned char* lds = (LAS unsigned char*)lds_raw;
    volatile LAS unsigned* MISC = (volatile LAS unsigned*)(lds + MISC_OFF);
    volatile LAS unsigned* PT = (volatile LAS unsigned*)(lds + PT_OFF);
    const int tid0 = threadIdx.x, wave = __builtin_amdgcn_readfirstlane(tid0 >> 6);
    const int tid = tid0, lane = tid0 & 63;
    const int G0 = gridDim.x, bid0 = blockIdx.x;
    const int G = G0, bid = bid0, gw = bid * NWAVES + wave, NGW = G * NWAVES;
    for (int u = tid; u < 256; u += NWAVES * 64) ((LAS unsigned*)(lds + LDSCTL_OFF))[u] = 0u;
    if (tid == 0) {
#pragma unroll
        for (int i = 0; i < 32; ++i) { const unsigned long long v = (unsigned long long)args.in[i]; PT[2 * i] = (unsigned)v; PT[2 * i + 1] = (unsigned)(v >> 32); }
        { const unsigned long long v = (unsigned long long)args.out; PT[64] = (unsigned)v; PT[65] = (unsigned)(v >> 32); }
        { const unsigned long long v = (unsigned long long)args.ws; PT[66] = (unsigned)v; PT[67] = (unsigned)(v >> 32); }
    }
    __syncthreads();
    const int lo = args.ph_lo, hi = args.ph_hi;
    XcdBarrier bar; { unsigned char* ws0 = (unsigned char*)pt_get(PT, 33); bar.bar = (unsigned*)(ws0 + WS_CTL) + CW_BAR; bar.x = 0; bar.st = nullptr;
        if (hi - lo > 1) bar = xcd_barrier_post((unsigned*)(ws0 + WS_CTL) + CW_BAR, MISC + 8); }
#define IN(k) (lo <= (k) && (k) < hi)
#define SEAM(k) do { if (IN(k) && IN((k) + 1)) { XcdBarrier b_ = bar; unsigned long long p_ = (unsigned long long)b_.bar; unsigned x_ = b_.x; asm volatile("" : "+s"(p_), "+s"(x_)); b_.bar = (unsigned*)p_; b_.x = x_; xcd_barrier(b_); } } while (0)
#define PIN(i) pt_get(PT, (i))
#define WSP() ((unsigned char*)pt_get(PT, 33))
#define OUTP() ((float*)pt_get(PT, 32))
#if RES_PINGPONG
#define XBUF(ws, k) ({ int x_ = (3 * l + (k)) & 1; asm volatile("" : "+s"(x_)); (bf16*)((ws) + (x_ ? WS_XN2 : WS_XN)); })
#else
#define XBUF(ws, k) ((bf16*)((ws) + WS_XN))
#endif
#define PSB(ws, i) ((float*)((ws) + WS_PSX + (size_t)(i) * PSX_BYTES))
#define RSB(ws, i) ((float*)((ws) + WS_RSX + (size_t)(i) * RSX_BYTES))
#if REDUCE8
#define REDUCE_ROWS(ps_, rs_) reduce_rows8((ps_), (rs_), gw, NGW)
#else
#define REDUCE_ROWS(ps_, rs_) reduce_rows((ps_), (rs_), gw, NGW, lane)
#endif
#define REP(kind) for (int rep_ = 0; rep_ < 1 + ((PROBE_MASK >> (kind)) & 1); ++rep_)
#define DUMMY_F32(ws) ((float*)((ws) + WS_END3))
#define OPQ_LANE() int tid = tid0; asm volatile("" : "+v"(tid)); const int lane = tid & 63; (void)lane

    if (IN(0)) REP(0) {
        unsigned char* ws = WSP(); bf16* Wb = (bf16*)(ws + WS_W); bf16* MEMN = (bf16*)(ws + WS_MEMN);
        LAS unsigned char* scr = lds + RING_OFF + wave * 16384;
        int p0_ofs = 0;
#pragma unroll 1
        for (int mi = 0; mi < 8 * DEPTH; ++mi) {
            const int l = mi >> 3, k = mi & 7; const float* W; int K, N; size_t off;
            if (k == 0) { W = PIN(3); K = D; N = IN_W; off = OW_IN; } else if (k == 1) { W = PIN(21); K = D; N = D; off = OW_OUT; }
            else if (k == 2) { W = PIN(24); K = D; N = MEM_W; off = OW_CQ; } else if (k == 3) { W = PIN(25); K = D; N = 2 * MEM_W; off = OW_CKV; }
            else if (k == 4) { W = PIN(28); K = MEM_W; N = D; off = OW_CO; } else if (k == 5) { W = PIN(30); K = D; N = DFF; off = OW_UP; }
            else if (k == 6) { W = PIN(31); K = DFF; N = D; off = OW_DOWN; } else { W = PIN(18); K = SSM_W; N = SSM_W; off = OW_GLU; }
            W += (size_t)l * K * N; bf16* WT = Wb + (size_t)l * W_LAYER + off;
            const float* gk = (k == 0) ? PIN(2) + (size_t)l * D : (k == 2) ? PIN(22) + (size_t)l * D : (k == 5) ? PIN(29) + (size_t)l * D : nullptr;
            const int nit = (K / 64) * (N / 64);
#if P0_PAIR
            { const int nblk = N / 64;
              for (int q = gw; q < nit / 2; q += NGW) { const int kb2 = q / nblk, nb = q - kb2 * nblk, itA = 2 * kb2 * nblk + nb;
                  p0_transpose_pair(W, K, N, WT, scr, itA, itA + nblk, lane, k == 0, gk); } }
#else
            { int it0 = gw - p0_ofs; if (it0 < 0) it0 += NGW;
              for (int it = it0; it < nit; it += NGW) p0_transpose_tile(W, K, N, WT, scr, it, lane, k == 0, gk);
              p0_ofs = (p0_ofs + nit) % NGW; }
#endif
        }
#pragma unroll 1
        for (int l = 0; l < DEPTH; ++l) rmsnorm_rows(PIN(1), PIN(23) + (size_t)l * D, MEMN + (size_t)l * MM * D, MM, gw, NGW, lane);
    }
    SEAM(0);

#pragma unroll 1
    for (int l = 0; l < DEPTH; ++l) {
        const int pb = 1 + NPH_LAYER * l;
        const int lane = opq_lane_id(), tid = wave * 64 + lane;
        int G = G0, bid = bid0; asm volatile("" : "+s"(G), "+s"(bid)); const int gw = bid * NWAVES + wave, NGW = G * NWAVES;
        if (IN(pb + 0)) REP(1) { unsigned char* ws = WSP();
            if (l == 0) xb_rows(PIN(0), (bf16*)(ws + WS_XN), RSB(ws, 0), gw, NGW, lane);
            else REDUCE_ROWS(PSB(ws, 3 * l - 1), RSB(ws, 3 * l)); }
        SEAM(pb + 0);
        if (IN(pb + 1)) REP(2) { unsigned char* ws = WSP(); const bf16* Wl = (const bf16*)(ws + WS_W) + (size_t)l * W_LAYER;
            pg8::Gemm g{(const bf16*)XBUF(ws, 0), Wl + OW_IN, M, IN_W, D}; pg8::StaticOrder So; So.init(M, IN_W, G, bid);
            pg8::EpiInproj E{(bf16*)(ws + WS_R + R_QKVC), RSB(ws, 3 * l)};
            pg8::gemm_phase<pg8::EpiInproj, pg8::StaticOrder, PG8_ALIGN, PG8_SP2>(lds + RING_OFF, g, So, E, wave); }
        SEAM(pb + 1);
        if (IN(pb + 2)) {
            unsigned char* ws = WSP(); bf16* QKVC = (bf16*)(ws + WS_R + R_QKVC);
            REP(3) for (int u = bid; u < NB * SSM_G; u += G)
#if USE_SSM_MFMA == 2
                ssm_unit_hybrid(u, l, PIN(10), PIN(11), PIN(12), PIN(13), PIN(14), PIN(15), PIN(16) + (size_t)l * SSM_W, PIN(17), QKVC + (size_t)8 * M * 1024, (bf16*)(ws + WS_R + R_Z), lds + RING_OFF, tid, wave, lane);
#elif USE_SSM_MFMA
                ssm_unit_mfma(u, l, PIN(10), PIN(11), PIN(12), PIN(13), PIN(14), PIN(15), PIN(16) + (size_t)l * SSM_W, PIN(17), QKVC + (size_t)8 * M * 1024, (bf16*)(ws + WS_R + R_Z), lds + RING_OFF, wave, lane);
#else
                ssm_unit(u, l, PIN(10), PIN(11), PIN(12), PIN(13), PIN(14), PIN(15), PIN(16) + (size_t)l * SSM_W, PIN(17), QKVC + (size_t)8 * M * 1024, (bf16*)(ws + WS_R + R_Z), lds + RING_OFF, tid, wave, lane);
#endif
            { const float* gq = PIN(4) + l * HD; const float* gk = PIN(5) + l * HD; LAS float* G2 = (LAS float*)(lds + LDSCTL_OFF + 2048);
              { const int t_ = wave * 64 + opq_lane_id(); if (t_ < HD) G2[t_] = ((const GAS float*)gq)[t_] * ((const GAS float*)gk)[t_] * (QK_SCALE * LOG2E); }
              LDS_WAIT(); __syncthreads();
              bf16* PART = (bf16*)(ws + WS_R + R_ATT); float* LSE = (float*)(ws + WS_R + R_LSE);
              const brsrc_t rsQ = mk_rsrc(QKVC, 2u * M * 1024 * 2), rsK = mk_rsrc(QKVC + (size_t)2 * M * 1024, 2u * M * 1024 * 2), rsV = mk_rsrc(QKVC + (size_t)4 * M * 1024, 2u * M * 1024 * 2), rsO = mk_rsrc(PART, 3u * M * ATTN_W * 2);
              const bool xo = ATT_XCD_ORDER && G == 256; const int xcd = bid & 7, u = (bid >> 3) * NWAVES + wave;
              REP(4) {
#pragma unroll 1
                for (int s = 0; ; ++s) { int it;
                    if (xo) { if (s >= 12) break; const int dp = s / 3, li = u + 256 * (s - 3 * dp), hi2 = li >= 384 ? 1 : 0, rem = li - 384 * hi2, pr = xcd + 8 * (2 * dp + hi2); it = ((rem >> 7) << 13) | (pr << 7) | (rem & 127); }
                    else { it = gw + s * NGW; if (it >= 3 * NH * NB * 128) break; }
                    attn_mfma_item2<0>(it, rsQ, rsK, rsV, rsO, LSE, G2, lds + RING_OFF + wave * 17024, lane); } } }
            { const float* dw = PIN(6) + (size_t)l * CONV_K * CONV_W; const float* cb = PIN(7) + l * CONV_W; const float* lng = PIN(8) + l * CONV_W; const float* lnb = PIN(9) + l * CONV_W;
              const float* gmix = PIN(20) + (size_t)l * D; bf16* MIXED = (bf16*)(ws + WS_R + R_MIXED);
              LDS_WAIT(); __syncthreads();
              conv_stage_weights(dw, lds + RING_OFF, wave * 64 + opq_lane_id());
              LDS_WAIT(); __syncthreads();
              REP(5) for (int t4 = gw; t4 < M / 4; t4 += NGW)
                CONV_ITEM(4 * t4, QKVC + (size_t)6 * M * 1024, lds + RING_OFF, cb, lng, lnb, gmix, MIXED, lane); }
        }
        SEAM(pb + 2);
        if (IN(pb + 3)) REP(6) { unsigned char* ws = WSP(); const bf16* Wl = (const bf16*)(ws + WS_W) + (size_t)l * W_LAYER; bf16* ZB = (bf16*)(ws + WS_R + R_Z);
            pg8::Gemm g{ZB, Wl + OW_GLU, M, SSM_W, SSM_W}; pg8::StaticOrder So; So.init(M, SSM_W, G, bid);
            pg8::EpiGlu E{(bf16*)(ws + WS_R + R_SG), ZB, SSM_W, PIN(19) + l * SSM_W};
            pg8::gemm_phase<pg8::EpiGlu, pg8::StaticOrder, PG8_ALIGN, PG8_SP2>(lds + RING_OFF, g, So, E, wave); }
        SEAM(pb + 3);
        if (IN(pb + 4)) REP(7) { unsigned char* ws = WSP(); const float* gmix = PIN(20) + (size_t)l * D;
#if POST_PAIR
            { int t = gw;
              for (; t + NGW < M; t += 2 * NGW) post_item2(t, t + NGW, (const bf16*)(ws + WS_R + R_ATT), (const float*)(ws + WS_R + R_LSE), (const bf16*)(ws + WS_R + R_SG), gmix, (bf16*)(ws + WS_R + R_MIXED), lane);
              if (t < M) post_item(t, (const bf16*)(ws + WS_R + R_ATT), (const float*)(ws + WS_R + R_LSE), (const bf16*)(ws + WS_R + R_SG), gmix, (bf16*)(ws + WS_R + R_MIXED), lane); } }
#else
            for (int t = gw; t < M; t += NGW) post_item(t, (const bf16*)(ws + WS_R + R_ATT), (const float*)(ws + WS_R + R_LSE), (const bf16*)(ws + WS_R + R_SG), gmix, (bf16*)(ws + WS_R + R_MIXED), lane); }
#endif
        SEAM(pb + 4);
        if (IN(pb + 5)) REP(8) { unsigned char* ws = WSP(); const bf16* Wl = (const bf16*)(ws + WS_W) + (size_t)l * W_LAYER; float* out = OUTP(); const float* xin = (l == 0) ? PIN(0) : (const float*)out;
            pg8::Gemm g{(const bf16*)(ws + WS_R + R_MIXED), Wl + OW_OUT, M, D, D}; pg8::StaticOrder So; So.init(M, D, G, bid);
#if RES_BF16
            (void)xin; (void)out;
            pg8::EpiResB E{(const bf16*)XBUF(ws, 0), nullptr, D, XBUF(ws, 1), PSB(ws, 3 * l), M};
            pg8::gemm_phase<pg8::EpiResB, pg8::StaticOrder, PG8_ALIGN, PG8_SP2>(lds + RING_OFF, g, So, E, wave); }
#else
            pg8::EpiRes E{xin, rep_ ? DUMMY_F32(ws) : out, D, (bf16*)(ws + WS_XN), PSB(ws, 3 * l), M};
            pg8::gemm_phase<pg8::EpiRes, pg8::StaticOrder, PG8_ALIGN, PG8_SP2>(lds + RING_OFF, g, So, E, wave); }
#endif
        SEAM(pb + 5);
        if (IN(pb + 6)) REP(1) { unsigned char* ws = WSP(); REDUCE_ROWS(PSB(ws, 3 * l), RSB(ws, 3 * l + 1)); }
        SEAM(pb + 6);
        if (IN(pb + 7)) REP(9) {
            unsigned char* ws = WSP(); const bf16* Wl = (const bf16*)(ws + WS_W) + (size_t)l * W_LAYER;
            const int ncq = (G >= 144) ? 128 : G, kv0 = (G >= 144) ? 128 : 0, nkv = (G >= 144) ? 16 : G;
            if (bid < ncq) { pg8::Gemm g{(const bf16*)XBUF(ws, 1), Wl + OW_CQ, M, MEM_W, D}; pg8::StaticOrder So; So.init(M, MEM_W, ncq, bid);
                pg8::EpiBf16<0> E{(bf16*)(ws + WS_QC), MEM_W, 0, 0, RSB(ws, 3 * l + 1)};
                pg8::gemm_phase<pg8::EpiBf16<0>, pg8::StaticOrder, PG8_ALIGN, PG8_SP2>(lds + RING_OFF, g, So, E, wave); }
            if (bid >= kv0 && bid < kv0 + nkv) { pg8::Gemm g{(const bf16*)(ws + WS_MEMN) + (size_t)l * MM * D, Wl + OW_CKV, MM, 2 * MEM_W, D}; pg8::StaticOrder So; So.init(MM, 2 * MEM_W, nkv, bid - kv0);
                pg8::EpiBf16<0> E{(bf16*)(ws + WS_KV) + (size_t)l * MM * 1024, 1024, 0, 0, nullptr};
                pg8::gemm_phase<pg8::EpiBf16<0>, pg8::StaticOrder, PG8_ALIGN, PG8_SP2>(lds + RING_OFF, g, So, E, wave); }
        }
        SEAM(pb + 7);
        if (IN(pb + 8)) REP(10) { unsigned char* ws = WSP(); LAS float* G2 = (LAS float*)(lds + LDSCTL_OFF + 2048);
            const bf16* KVl = (const bf16*)(ws + WS_KV) + (size_t)l * MM * 1024; const float* gq = PIN(26) + l * HD; const float* gk = PIN(27) + l * HD;
            { const int t_ = wave * 64 + opq_lane_id(); if (t_ < HD) G2[t_] = ((const GAS float*)gq)[t_] * ((const GAS float*)gk)[t_] * (QK_SCALE * LOG2E); }
            LDS_WAIT(); __syncthreads();
            const brsrc_t rsQ = mk_rsrc(ws + WS_QC, (unsigned)M * MEM_W * 2), rsK = mk_rsrc(KVl, (unsigned)MM * 1024 * 2), rsV = mk_rsrc(KVl + MEM_W, (unsigned)(MM * 1024 - MEM_W) * 2), rsO = mk_rsrc(ws + WS_OC, (unsigned)M * MEM_W * 2);
            for (int it = gw; it < NMH * (M / 32); it += NGW) attn_mfma_item2<1>(it, rsQ, rsK, rsV, rsO, nullptr, G2, lds + RING_OFF + wave * 17024, lane); }
        SEAM(pb + 8);
        if (IN(pb + 9)) REP(11) { unsigned char* ws = WSP(); const bf16* Wl = (const bf16*)(ws + WS_W) + (size_t)l * W_LAYER; float* out = OUTP();
            pg8::Gemm g{(const bf16*)(ws + WS_OC), Wl + OW_CO, M, D, MEM_W}; pg8::StaticOrder So; So.init(M, D, G, bid);
#if RES_BF16
            (void)out;
            pg8::EpiResB E{(const bf16*)XBUF(ws, 1), nullptr, D, XBUF(ws, 2), PSB(ws, 3 * l + 1), M};
            pg8::gemm_phase<pg8::EpiResB, pg8::StaticOrder, PG8_ALIGN, PG8_SP2>(lds + RING_OFF, g, So, E, wave); }
#else
            pg8::EpiRes E{out, rep_ ? DUMMY_F32(ws) : out, D, (bf16*)(ws + WS_XN), PSB(ws, 3 * l + 1), M};
            pg8::gemm_phase<pg8::EpiRes, pg8::StaticOrder, PG8_ALIGN, PG8_SP2>(lds + RING_OFF, g, So, E, wave); }
#endif
        SEAM(pb + 9);
        if (IN(pb + 10)) REP(1) { unsigned char* ws = WSP(); REDUCE_ROWS(PSB(ws, 3 * l + 1), RSB(ws, 3 * l + 2)); }
        SEAM(pb + 10);
        if (IN(pb + 11)) REP(12) { unsigned char* ws = WSP(); const bf16* Wl = (const bf16*)(ws + WS_W) + (size_t)l * W_LAYER;
            pg8::Gemm g{(const bf16*)XBUF(ws, 2), Wl + OW_UP, M, DFF, D}; pg8::StaticOrder So; So.init(M, DFF, G, bid);
            pg8::EpiBf16<3> E{(bf16*)(ws + WS_R + R_H), DFF, 0, 0, RSB(ws, 3 * l + 2)};
            pg8::gemm_phase<pg8::EpiBf16<3>, pg8::StaticOrder, PG8_ALIGN, PG8_SP2>(lds + RING_OFF, g, So, E, wave);
            }
        SEAM(pb + 11);
        if (IN(pb + 12)) REP(13) { unsigned char* ws = WSP(); const bf16* Wl = (const bf16*)(ws + WS_W) + (size_t)l * W_LAYER; float* out = OUTP();
            pg8::Gemm g{(const bf16*)(ws + WS_R + R_H), Wl + OW_DOWN, M, D, DFF}; pg8::StaticOrder So; So.init(M, D, G, bid);
#if RES_BF16
            pg8::EpiResB E{(const bf16*)XBUF(ws, 2), (l + 1 < DEPTH) ? nullptr : out, D, (l + 1 < DEPTH) ? XBUF(ws, 3) : nullptr, PSB(ws, 3 * l + 2), M};
            pg8::gemm_phase<pg8::EpiResB, pg8::StaticOrder, PG8_ALIGN, PG8_SP2>(lds + RING_OFF, g, So, E, wave); }
#else
            pg8::EpiRes E{out, rep_ ? DUMMY_F32(ws) : out, D, (l + 1 < DEPTH) ? (bf16*)(ws + WS_XN) : nullptr, PSB(ws, 3 * l + 2), M};
            pg8::gemm_phase<pg8::EpiRes, pg8::StaticOrder, PG8_ALIGN, PG8_SP2>(lds + RING_OFF, g, So, E, wave); }
#endif
        SEAM(pb + 12);
    }
#undef IN
#undef SEAM
}

extern "C" void kernel_launch(void* const* d_in, const int* in_sizes, int n_in, void* d_out, int out_size, void* d_ws, size_t ws_size, hipStream_t stream) {
    static int grid = 0;
    if (grid == 0) {
        if (n_in != 32 || in_sizes[0] != M * D || out_size != M * D || ws_size < WS_END3 + (PROBE_MASK ? (size_t)M * D * 4 : 0)) { fprintf(stderr, "kernel_launch: unexpected shapes (n_in %d, in0 %d, out %d, ws %zu < %zu); nothing launched\n", n_in, n_in > 0 ? in_sizes[0] : -1, out_size, ws_size, (size_t)WS_END); grid = -1; return; }
        int dev = 0, cus = 0, per_cu = 0;
        if (hipGetDevice(&dev) != hipSuccess || hipDeviceGetAttribute(&cus, hipDeviceAttributeMultiprocessorCount, dev) != hipSuccess) { fprintf(stderr, "kernel_launch: device query failed\n"); grid = -1; return; }
        if (hipFuncSetAttribute((const void*)fwd, hipFuncAttributeMaxDynamicSharedMemorySize, LDS_BYTES) != hipSuccess) { fprintf(stderr, "kernel_launch: hipFuncSetAttribute failed\n"); grid = -1; return; }
        if (hipOccupancyMaxActiveBlocksPerMultiprocessor(&per_cu, (const void*)fwd, NWAVES * 64, LDS_BYTES) != hipSuccess || per_cu < 1)
            fprintf(stderr, "kernel_launch: note: occupancy query reports %d workgroups per CU\n", per_cu);
        (void)hipGetLastError();
        grid = cus;
    }
    if (grid < 0) return;
    if (hipMemsetAsync((char*)d_ws + WS_CTL, 0, CTL_ZERO_BYTES, stream) != hipSuccess) { fprintf(stderr, "kernel_launch: memset failed\n"); return; }
#if PROBE_ZERO_WS
    (void)hipMemsetAsync((char*)d_ws + CTL_ZERO_BYTES, 0, WS_END - CTL_ZERO_BYTES, stream); (void)hipMemsetAsync(d_out, 0, (size_t)M * D * 4, stream);
#endif
    Args a{};
    for (int i = 0; i < 32; ++i) a.in[i] = (const float*)d_in[i];
    a.out = (float*)d_out; a.ws = (unsigned char*)d_ws;
#if MK_ONE_LAUNCH
    a.ph_lo = 0; a.ph_hi = NPH;
    hipLaunchKernelGGL(fwd, dim3(grid), dim3(NWAVES * 64), LDS_BYTES, stream, a);
#else
    for (int p = 0; p < NPH; ++p) { a.ph_lo = p; a.ph_hi = p + 1; hipLaunchKernelGGL(fwd, dim3(grid), dim3(NWAVES * 64), LDS_BYTES, stream, a); }
#endif
    const hipError_t le = hipPeekAtLastError();
    if (le != hipSuccess) fprintf(stderr, "kernel_launch: launch failed: %s\n", hipGetErrorName(le));
}
```

```cpp
#include <hip/hip_runtime.h>
#include <cstdio>
#include <cstdint>
#ifndef MK_ONE_LAUNCH
#define MK_ONE_LAUNCH 1
#endif
#ifndef PROBE_MASK
#define PROBE_MASK 0
#endif
#ifndef PROBE_ZERO_WS
#define PROBE_ZERO_WS 0
#endif
#ifndef USE_SSM_MFMA
#define USE_SSM_MFMA 1
#endif
#ifndef ATT_PREFETCH
#define ATT_PREFETCH 2
#endif
#ifndef USE_SWZ
#define USE_SWZ 0
#endif
#ifndef ATT_DEFER_MAX
#define ATT_DEFER_MAX 0
#endif
#ifndef ATT_GRAM
#define ATT_GRAM 1
#endif
#ifndef ATT_LSUM_LATE
#define ATT_LSUM_LATE 1
#endif
#ifndef ATT_XCD_ORDER
#define ATT_XCD_ORDER 1
#endif
#ifndef RES_BF16
#define RES_BF16 1
#endif
#ifndef RES_PINGPONG
#define RES_PINGPONG 1
#endif
#ifndef CONV_PIPE
#define CONV_PIPE 1
#endif
#if CONV_PIPE
#define CONV_ITEM conv_item4p
#else
#define CONV_ITEM conv_item4w
#endif
#ifndef ATT_EARLY_PF
#define ATT_EARLY_PF 1
#endif
#ifndef P0_PAIR
#define P0_PAIR 0
#endif
#ifndef EPI_ST_SC1
#define EPI_ST_SC1 0
#endif
#ifndef POST_PAIR
#define POST_PAIR 1
#endif
#ifndef REDUCE8
#define REDUCE8 1
#endif
namespace pg8 {
#define PG8_LAS __attribute__((address_space(3)))
typedef unsigned short bf16_t;
typedef short bf16x8 __attribute__((ext_vector_type(8)));
typedef float f32x4 __attribute__((ext_vector_type(4)));
typedef unsigned u32x4 __attribute__((ext_vector_type(4)));
constexpr int BM = 256, BK = 64, HALF = 128, HTB = HALF * BK * 2  , STAGE_BYTES = 8 * HTB, NXCD = 8, WGM = 8;

__host__ __device__ __forceinline__ int lds_byte(int r, int c) { const int st = (r >> 4) * 2 + (c >> 5), rr = r & 15, cc = c & 31, ob = rr * 64 + cc * 2; return st * 1024 + (ob ^ (((ob >> 9) & 1) << 5)); }
__host__ __device__ __forceinline__ void stage_rc(int b, int& R, int& C) { const int st = b / 1024, sb = b % 1024, swz = sb ^ (((sb >> 9) & 1) << 5); R = (st >> 1) * 16 + swz / 64; C = (st & 1) * 32 + (swz % 64) / 2; }
__host__ __device__ __forceinline__ int perm32(int rho) { const int n = rho >> 4, i = rho & 15; return 8 * (i >> 2) + 4 * n + (i & 3); }

struct Unit { int pm, pn; };
struct Gemm { const bf16_t* A; const bf16_t* Bt; int M, N, K; };

struct StaticOrder {
    int nM, nN, nwg, G, c;
    __host__ __device__ void init(int M, int N, int G_, int c_) { nM = M / BM; nN = N / BM; nwg = nM * nN; G = G_; c = c_; }
    __host__ __device__ bool next(int i, Unit& u) const {
        const long L = (long)i * G + c; if (L >= nwg) return false;
        int wgid = (int)L; { const int q = nwg / NXCD, r = nwg % NXCD, xcd = wgid % NXCD, off = wgid / NXCD; wgid = (xcd < r ? xcd * (q + 1) : r * (q + 1) + (xcd - r) * q) + off; }
        const int nig = WGM * nN, gid = wgid / nig, fm = gid * WGM, gsz = (nM - fm) < WGM ? (nM - fm) : WGM;
        u.pm = fm + ((wgid % nig) % gsz); u.pn = (wgid % nig) / gsz; return true;
    }
    __device__ __forceinline__ void a_ready(const Unit&) const {}
    __device__ __forceinline__ void done(const Unit&) const {}
};

__device__ __forceinline__ unsigned cvt_pk_bf16(float lo, float hi) { unsigned r; asm volatile("v_cvt_pk_bf16_f32 %0, %1, %2" : "=v"(r) : "v"(lo), "v"(hi)); return r; }
typedef float f32x2 __attribute__((ext_vector_type(2)));
#define PG8_GAS __attribute__((address_space(1)))
#if EPI_ST_SC1
__device__ __forceinline__ void pg8_st16_wt(PG8_GAS void* p, u32x4 v) { asm volatile("global_store_dwordx4 %0, %1, off sc1" :: "v"(p), "v"(v) : "memory"); }
#define PG8_ST16(ptr, val) pg8_st16_wt((PG8_GAS void*)(ptr), (val))
#else
#define PG8_ST16(ptr, val) (*(PG8_GAS u32x4*)(ptr) = (val))
#endif
__device__ __forceinline__ float bf_lo(unsigned w) { return __uint_as_float(w << 16); }
__device__ __forceinline__ float bf_hi(unsigned w) { return __uint_as_float(w & 0xffff0000u); }
__device__ __forceinline__ float sigmoid_f(float x) { return __builtin_amdgcn_rcpf(1.0f + __expf(-x)); }

template <int ACT> struct EpiBf16 {
    static constexpr bool PERM = true, AFTER_DRAIN = false;
    bf16_t* O; int ldc; int split_cols; size_t split_stride; const float* rs;
    __device__ __forceinline__ void operator()(const f32x4 (&acc)[2][2][4][2], const Unit& u, int wr, int wc, int fr, int fq) const {
        const int row0 = u.pm * BM + wr * 64 + fr; int colt = u.pn * BM; bf16_t* base = O;
        if (split_cols) { const int t = colt / split_cols; base += (size_t)t * split_stride; colt -= t * split_cols; }
        const int col0 = colt + wc * 32 + 8 * fq;
        float scv[2][4];
#pragma unroll
        for (int ai = 0; ai < 2; ++ai)
#pragma unroll
            for (int m = 0; m < 4; ++m) scv[ai][m] = rs ? ((const PG8_GAS float*)rs)[row0 + ai * HALF + m * 16] : 1.f;
#pragma unroll
        for (int ai = 0; ai < 2; ++ai)
#pragma unroll
            for (int m = 0; m < 4; ++m) { bf16_t* rowp = base + (size_t)(row0 + ai * HALF + m * 16) * ldc + col0;
                const float sc = scv[ai][m];
#pragma unroll
                for (int bj = 0; bj < 2; ++bj) { f32x4 v0 = acc[ai][bj][m][0] * sc, v1 = acc[ai][bj][m][1] * sc;
                    if (ACT == 3) {
#pragma unroll
                        for (int j = 0; j < 4; ++j) { const float a = fmaxf(v0[j], 0.f), b = fmaxf(v1[j], 0.f); v0[j] = a * a; v1[j] = b * b; } }
                    u32x4 w; w.x = cvt_pk_bf16(v0[0], v0[1]); w.y = cvt_pk_bf16(v0[2], v0[3]); w.z = cvt_pk_bf16(v1[0], v1[1]); w.w = cvt_pk_bf16(v1[2], v1[3]);
                    PG8_ST16(rowp + bj * HALF, w); } }
    }
};
struct EpiGlu {
    static constexpr bool PERM = true, AFTER_DRAIN = false;
    bf16_t* O; const bf16_t* Z; int ldc; const float* bias;
    __device__ __forceinline__ void operator()(const f32x4 (&acc)[2][2][4][2], const Unit& u, int wr, int wc, int fr, int fq) const {
        const int row0 = u.pm * BM + wr * 64 + fr; const int col0 = u.pn * BM + wc * 32 + 8 * fq;
        f32x4 bv[2][2];
#pragma unroll
        for (int bj = 0; bj < 2; ++bj)
#pragma unroll
            for (int n = 0; n < 2; ++n) bv[bj][n] = *(const PG8_GAS f32x4*)(bias + col0 + bj * HALF + 4 * n);
#pragma unroll
        for (int ai = 0; ai < 2; ++ai) {
            u32x4 zr[4][2];
#pragma unroll
            for (int m = 0; m < 4; ++m) { const PG8_GAS bf16_t* p = (const PG8_GAS bf16_t*)Z + (size_t)(row0 + ai * HALF + m * 16) * ldc + col0;
                asm volatile("global_load_dwordx4 %0, %2, off\n\tglobal_load_dwordx4 %1, %2, off offset:256" : "=&v"(zr[m][0]), "=&v"(zr[m][1]) : "v"(p) : "memory"); }
            asm volatile("s_waitcnt vmcnt(0)" : "+v"(zr[0][0]), "+v"(zr[0][1]), "+v"(zr[1][0]), "+v"(zr[1][1]), "+v"(zr[2][0]), "+v"(zr[2][1]), "+v"(zr[3][0]), "+v"(zr[3][1]) :: "memory");
#pragma unroll
            for (int m = 0; m < 4; ++m) { const size_t ro = (size_t)(row0 + ai * HALF + m * 16) * ldc + col0;
#pragma unroll
                for (int bj = 0; bj < 2; ++bj) { const f32x4 g0 = acc[ai][bj][m][0] + bv[bj][0], g1 = acc[ai][bj][m][1] + bv[bj][1];
                    const u32x4 zz = zr[m][bj];
                    const float o0 = bf_lo(zz.x) * sigmoid_f(g0[0]), o1 = bf_hi(zz.x) * sigmoid_f(g0[1]), o2 = bf_lo(zz.y) * sigmoid_f(g0[2]), o3 = bf_hi(zz.y) * sigmoid_f(g0[3]);
                    const float o4 = bf_lo(zz.z) * sigmoid_f(g1[0]), o5 = bf_hi(zz.z) * sigmoid_f(g1[1]), o6 = bf_lo(zz.w) * sigmoid_f(g1[2]), o7 = bf_hi(zz.w) * sigmoid_f(g1[3]);
                    u32x4 w; w.x = cvt_pk_bf16(o0, o1); w.y = cvt_pk_bf16(o2, o3); w.z = cvt_pk_bf16(o4, o5); w.w = cvt_pk_bf16(o6, o7);
                    PG8_ST16(O + ro + bj * HALF, w); } }
            asm volatile("" ::: "memory"); }
    }
};
struct EpiRes {
    static constexpr bool PERM = true, AFTER_DRAIN = false;
    const float* R; float* C; int ldc; bf16_t* XB; float* PS; int Mrows;
    __device__ __forceinline__ void operator()(const f32x4 (&acc)[2][2][4][2], const Unit& u, int wr, int wc, int fr, int fq) const {
        const int row0 = u.pm * BM + wr * 64 + fr, col0 = u.pn * BM + wc * 32 + 8 * fq; const int lane = fq * 16 + fr;
        f32x4 ra[4], rb[4];
        { const size_t off = (size_t)row0 * ldc + col0;
#pragma unroll
          for (int bj = 0; bj < 2; ++bj) { ra[2 * bj] = *(const PG8_GAS f32x4*)(R + off + bj * HALF); ra[2 * bj + 1] = *(const PG8_GAS f32x4*)(R + off + bj * HALF + 4); } }
#pragma unroll
        for (int g = 0; g < 8; ++g) { const int ai = g >> 2, m = g & 3; const size_t off = (size_t)(row0 + ai * HALF + m * 16) * ldc + col0; float s = 0.f;
            if (g < 7) { const int ai2 = (g + 1) >> 2, m2 = (g + 1) & 3; const size_t off2 = (size_t)(row0 + ai2 * HALF + m2 * 16) * ldc + col0;
#pragma unroll
                for (int bj = 0; bj < 2; ++bj) { rb[2 * bj] = *(const PG8_GAS f32x4*)(R + off2 + bj * HALF); rb[2 * bj + 1] = *(const PG8_GAS f32x4*)(R + off2 + bj * HALF + 4); } }
#pragma unroll
            for (int bj = 0; bj < 2; ++bj) {
                const f32x4 v0 = ra[2 * bj] + acc[ai][bj][m][0], v1 = ra[2 * bj + 1] + acc[ai][bj][m][1];
                *(PG8_GAS f32x4*)(C + off + bj * HALF) = v0; *(PG8_GAS f32x4*)(C + off + bj * HALF + 4) = v1;
                if (XB) { s += ((v0[0] * v0[0] + v0[1] * v0[1]) + (v0[2] * v0[2] + v0[3] * v0[3])) + ((v1[0] * v1[0] + v1[1] * v1[1]) + (v1[2] * v1[2] + v1[3] * v1[3]));
                    u32x4 w; w.x = cvt_pk_bf16(v0[0], v0[1]); w.y = cvt_pk_bf16(v0[2], v0[3]); w.z = cvt_pk_bf16(v1[0], v1[1]); w.w = cvt_pk_bf16(v1[2], v1[3]);
                    *(PG8_GAS u32x4*)(XB + off + bj * HALF) = w; } }
            if (XB) { s += __builtin_bit_cast(float, __builtin_amdgcn_ds_bpermute((lane ^ 16) << 2, __builtin_bit_cast(int, s))); s += __builtin_bit_cast(float, __builtin_amdgcn_ds_bpermute((lane ^ 32) << 2, __builtin_bit_cast(int, s)));
                if (fq == 0) ((PG8_GAS float*)PS)[(size_t)(u.pn * 4 + wc) * Mrows + row0 + ai * HALF + m * 16] = s; }
#pragma unroll
            for (int q = 0; q < 4; ++q) ra[q] = rb[q];
            asm volatile("" ::: "memory"); }
    }
};

struct EpiResB {
    static constexpr bool PERM = true, AFTER_DRAIN = false;
    const bf16_t* R; float* C; int ldc; bf16_t* XB; float* PS; int Mrows;
    __device__ __forceinline__ void operator()(const f32x4 (&acc)[2][2][4][2], const Unit& u, int wr, int wc, int fr, int fq) const {
        const int row0 = u.pm * BM + wr * 64 + fr, col0 = u.pn * BM + wc * 32 + 8 * fq; const int lane = fq * 16 + fr;
        u32x4 r[8][2];
#pragma unroll
        for (int g = 0; g < 8; ++g) { const PG8_GAS bf16_t* p = (const PG8_GAS bf16_t*)R + (size_t)(row0 + (g >> 2) * HALF + (g & 3) * 16) * ldc + col0;
            asm volatile("global_load_dwordx4 %0, %2, off\n\tglobal_load_dwordx4 %1, %2, off offset:256" : "=&v"(r[g][0]), "=&v"(r[g][1]) : "v"(p) : "memory"); }
        asm volatile("s_waitcnt vmcnt(0)" : "+v"(r[0][0]), "+v"(r[0][1]), "+v"(r[1][0]), "+v"(r[1][1]), "+v"(r[2][0]), "+v"(r[2][1]), "+v"(r[3][0]), "+v"(r[3][1]) :: "memory");
        asm volatile("" : "+v"(r[4][0]), "+v"(r[4][1]), "+v"(r[5][0]), "+v"(r[5][1]), "+v"(r[6][0]), "+v"(r[6][1]), "+v"(r[7][0]), "+v"(r[7][1]) :: "memory");
#pragma unroll
        for (int g = 0; g < 8; ++g) { const int ai = g >> 2, m = g & 3; const size_t off = (size_t)(row0 + ai * HALF + m * 16) * ldc + col0; float s = 0.f;
#pragma unroll
            for (int bj = 0; bj < 2; ++bj) { const u32x4 rr = r[g][bj];
                f32x4 v0, v1;
                v0[0] = __builtin_bit_cast(float, rr.x << 16); v0[1] = __builtin_bit_cast(float, rr.x & 0xffff0000u); v0[2] = __builtin_bit_cast(float, rr.y << 16); v0[3] = __builtin_bit_cast(float, rr.y & 0xffff0000u);
                v1[0] = __builtin_bit_cast(float, rr.z << 16); v1[1] = __builtin_bit_cast(float, rr.z & 0xffff0000u); v1[2] = __builtin_bit_cast(float, rr.w << 16); v1[3] = __builtin_bit_cast(float, rr.w & 0xffff0000u);
                v0 += acc[ai][bj][m][0]; v1 += acc[ai][bj][m][1];
                if (C) { *(PG8_GAS f32x4*)(C + off + bj * HALF) = v0; *(PG8_GAS f32x4*)(C + off + bj * HALF + 4) = v1; }
                if (XB) { s += ((v0[0] * v0[0] + v0[1] * v0[1]) + (v0[2] * v0[2] + v0[3] * v0[3])) + ((v1[0] * v1[0] + v1[1] * v1[1]) + (v1[2] * v1[2] + v1[3] * v1[3]));
                    u32x4 w; w.x = cvt_pk_bf16(v0[0], v0[1]); w.y = cvt_pk_bf16(v0[2], v0[3]); w.z = cvt_pk_bf16(v1[0], v1[1]); w.w = cvt_pk_bf16(v1[2], v1[3]);
                    *(PG8_GAS u32x4*)(XB + off + bj * HALF) = w; } }
            if (XB) { s += __builtin_bit_cast(float, __builtin_amdgcn_ds_bpermute((lane ^ 16) << 2, __builtin_bit_cast(int, s))); s += __builtin_bit_cast(float, __builtin_amdgcn_ds_bpermute((lane ^ 32) << 2, __builtin_bit_cast(int, s)));
                if (fq == 0) ((PG8_GAS float*)PS)[(size_t)(u.pn * 4 + wc) * Mrows + row0 + ai * HALF + m * 16] = s; } }
        asm volatile("" ::: "memory");
    }
};

struct EpiInproj {
    static constexpr bool PERM = true, AFTER_DRAIN = false;
    bf16_t* O; const float* rs;
    __device__ __forceinline__ void operator()(const f32x4 (&acc)[2][2][4][2], const Unit& u, int wr, int wc, int fr, int fq) const {
        const int row0 = u.pm * BM + wr * 64 + fr; const size_t TS = (size_t)16384 * 1024;
        float scv[2][4];
#pragma unroll
        for (int ai = 0; ai < 2; ++ai)
#pragma unroll
            for (int m = 0; m < 4; ++m) scv[ai][m] = ((const PG8_GAS float*)rs)[row0 + ai * HALF + m * 16];
        if (u.pn >= 24 && u.pn < 32) {
            bf16_t* base = O + 6 * TS + 128 * (u.pn - 24) + wc * 32 + 8 * fq;
#pragma unroll
            for (int ai = 0; ai < 2; ++ai)
#pragma unroll
                for (int m = 0; m < 4; ++m) { const float sc = scv[ai][m];
                    const f32x4 a0 = acc[ai][0][m][0] * sc, a1 = acc[ai][0][m][1] * sc, g0 = acc[ai][1][m][0] * sc, g1 = acc[ai][1][m][1] * sc;
                    u32x4 w; w.x = cvt_pk_bf16(a0[0] * sigmoid_f(g0[0]), a0[1] * sigmoid_f(g0[1])); w.y = cvt_pk_bf16(a0[2] * sigmoid_f(g0[2]), a0[3] * sigmoid_f(g0[3]));
                    w.z = cvt_pk_bf16(a1[0] * sigmoid_f(g1[0]), a1[1] * sigmoid_f(g1[1])); w.w = cvt_pk_bf16(a1[2] * sigmoid_f(g1[2]), a1[3] * sigmoid_f(g1[3]));
                    PG8_ST16(base + (size_t)(row0 + ai * HALF + m * 16) * 1024, w); }
        } else {
            const int colt = u.pn * BM; const int t = u.pn >= 32 ? 8 : colt >> 10; const int cin = u.pn >= 32 ? colt - 8192 : colt & 1023;
            bf16_t* base = O + (size_t)t * TS + cin + wc * 32 + 8 * fq;
#pragma unroll
            for (int ai = 0; ai < 2; ++ai)
#pragma unroll
                for (int m = 0; m < 4; ++m) { bf16_t* rowp = base + (size_t)(row0 + ai * HALF + m * 16) * 1024; const float sc = scv[ai][m];
#pragma unroll
                    for (int bj = 0; bj < 2; ++bj) { const f32x4 v0 = acc[ai][bj][m][0] * sc, v1 = acc[ai][bj][m][1] * sc;
                        u32x4 w; w.x = cvt_pk_bf16(v0[0], v0[1]); w.y = cvt_pk_bf16(v0[2], v0[3]); w.z = cvt_pk_bf16(v1[0], v1[1]); w.w = cvt_pk_bf16(v1[2], v1[3]);
                        PG8_ST16(rowp + bj * HALF, w); } }
        }
    }
};

template <class Epi, class Sched, bool ALIGN_EPI = false, bool SP2 = false>
__device__ __forceinline__ void gemm_phase(PG8_LAS unsigned char* lds, const Gemm g, const Sched& S, const Epi& E, int wv  ) {
    int lane_ = (int)__builtin_amdgcn_mbcnt_hi(~0u, __builtin_amdgcn_mbcnt_lo(~0u, 0u)); asm volatile("" : "+v"(lane_));
    const int wid = wv, lane = lane_, tid = wid * 64 + lane, wr = wid >> 2, wc = wid & 3, fr = lane & 15, fq = lane >> 4;
    const int K = g.K, nt = K / BK;
    unsigned voffA[2], voffB[2];
#pragma unroll
    for (int i = 0; i < 2; ++i) { int R, C; stage_rc(tid * 16 + i * 8192, R, C); const int Rb = Epi::PERM ? ((R & ~31) + perm32(R & 31)) : R;
        voffA[i] = (unsigned)(R * K + C) * 2u; voffB[i] = (unsigned)(Rb * K + C) * 2u; }
    const size_t kstep = (size_t)(BK * 2);
    const size_t hstep = (size_t)HALF * K * 2;
    const size_t tstep = 2 * hstep;
    const unsigned ldsw = (unsigned)wid * 1024u;
    const int aoff = lds_byte(wr * 64 + fr, fq * 8), boff = lds_byte(wc * 32 + fr, fq * 8);
#define PG8_SA(b, h) (((b) * 2 + (h)) * HTB)
#define PG8_SB(b, h) ((4 + (b) * 2 + (h)) * HTB)
#define PG8_STAGE(bufoff, gbase, voff) do { _Pragma("unroll") for (int _i = 0; _i < 2; ++_i) \
        __builtin_amdgcn_global_load_lds((const unsigned*)((const char*)(gbase) + (voff)[_i]), (PG8_LAS unsigned*)(lds + (bufoff) + ldsw + _i * 8192), 16, 0, 0); } while (0)
#define PG8_LDA(dst, b, h) do { _Pragma("unroll") for (int m = 0; m < 4; ++m) _Pragma("unroll") for (int k = 0; k < 2; ++k) dst[m][k] = *(const PG8_LAS bf16x8*)(lds + PG8_SA(b, h) + aoff + m * 2048 + k * 1024); } while (0)
#define PG8_LDB(dst, b, h) do { _Pragma("unroll") for (int n = 0; n < 2; ++n) _Pragma("unroll") for (int k = 0; k < 2; ++k) dst[n][k] = *(const PG8_LAS bf16x8*)(lds + PG8_SB(b, h) + boff + n * 2048 + k * 1024); } while (0)
#define PG8_MMA(ai, bj, At, Bt) do { __builtin_amdgcn_s_setprio(1); _Pragma("unroll") for (int m = 0; m < 4; ++m) _Pragma("unroll") for (int n = 0; n < 2; ++n) _Pragma("unroll") for (int k = 0; k < 2; ++k) \
        acc[ai][bj][m][n] = __builtin_amdgcn_mfma_f32_16x16x32_bf16(Bt[n][k], At[m][k], acc[ai][bj][m][n], 0, 0, 0); __builtin_amdgcn_s_setprio(0); } while (0)
#define PG8_WAIT_V(n) asm volatile("s_waitcnt vmcnt(" #n ")" ::: "memory")
#define PG8_WAIT_L(n) asm volatile("s_waitcnt lgkmcnt(" #n ")" ::: "memory")
#define PG8_BAR __builtin_amdgcn_s_barrier()
#define PG8_SCHED __builtin_amdgcn_sched_barrier(0)
    Unit cur, nxt; int ui = 0;
    if (!S.next(0, cur)) return;
    f32x4 acc[2][2][4][2];
#pragma unroll
    for (int a = 0; a < 2; ++a)
#pragma unroll
        for (int b = 0; b < 2; ++b)
#pragma unroll
            for (int m = 0; m < 4; ++m)
#pragma unroll
                for (int n = 0; n < 2; ++n) acc[a][b][m][n] = (f32x4){0.f, 0.f, 0.f, 0.f};
    bf16x8 At[4][2], B0[2][2], B1[2][2];
    const char* cA = (const char*)g.A + (size_t)cur.pm * tstep; const char* cB = (const char*)g.Bt + (size_t)cur.pn * tstep;
    S.a_ready(cur);
    if constexpr (SP2) {
        PG8_STAGE(PG8_SB(0, 0), cB, voffB); PG8_STAGE(PG8_SB(0, 1), cB + hstep, voffB); PG8_STAGE(PG8_SA(0, 0), cA, voffA); PG8_STAGE(PG8_SA(0, 1), cA + hstep, voffA);
        if (wr == 1) PG8_BAR;
        PG8_WAIT_V(2); PG8_BAR;
        PG8_STAGE(PG8_SB(1, 0), cB + kstep, voffB); PG8_STAGE(PG8_SA(1, 0), cA + kstep, voffA); PG8_STAGE(PG8_SB(1, 1), cB + hstep + kstep, voffB);
        PG8_WAIT_V(6); PG8_BAR;
    } else {
        PG8_STAGE(PG8_SB(0, 0), cB, voffB); PG8_STAGE(PG8_SA(0, 0), cA, voffA); PG8_STAGE(PG8_SB(0, 1), cB + hstep, voffB); PG8_STAGE(PG8_SA(0, 1), cA + hstep, voffA);
        if (wr == 1) PG8_BAR;
        PG8_WAIT_V(4); PG8_BAR;
        PG8_STAGE(PG8_SB(1, 0), cB + kstep, voffB); PG8_STAGE(PG8_SA(1, 0), cA + kstep, voffA); PG8_STAGE(PG8_SB(1, 1), cB + hstep + kstep, voffB);
        PG8_WAIT_V(6); PG8_BAR;
    }
    for (;;) {
        const bool has_next = S.next(ui + 1, nxt);
        const char* nA = has_next ? (const char*)g.A + (size_t)nxt.pm * tstep : cA; const char* nB = has_next ? (const char*)g.Bt + (size_t)nxt.pn * tstep : cB;
        for (int t = 0; t < nt; t += 2) {
            const bool last = (t == nt - 2);
            const char* a1 = cA + (size_t)(t + 1) * kstep;
            const char* a2 = last ? nA : cA + (size_t)(t + 2) * kstep; const char* b2 = last ? nB : cB + (size_t)(t + 2) * kstep;
            const char* a3 = a2 + kstep; const char* b3 = b2 + kstep;
            if (last && has_next) S.a_ready(nxt);
            if constexpr (SP2) {
            PG8_LDB(B0, 0, 0); PG8_LDB(B1, 0, 1); PG8_SCHED; PG8_LDA(At, 0, 0); PG8_STAGE(PG8_SA(1, 1), a1 + hstep, voffA);
            PG8_WAIT_V(8); PG8_WAIT_L(0); PG8_BAR; PG8_MMA(0, 0, At, B0); PG8_MMA(0, 1, At, B1); PG8_BAR; PG8_SCHED;
            PG8_LDA(At, 0, 1); PG8_STAGE(PG8_SB(0, 0), b2, voffB); PG8_STAGE(PG8_SB(0, 1), b2 + hstep, voffB); PG8_STAGE(PG8_SA(0, 0), a2, voffA);
            PG8_WAIT_V(8); PG8_WAIT_L(0); PG8_BAR; PG8_MMA(1, 0, At, B0); PG8_MMA(1, 1, At, B1); PG8_BAR; PG8_SCHED;
            PG8_LDB(B0, 1, 0); PG8_LDB(B1, 1, 1); PG8_SCHED; PG8_LDA(At, 1, 0); PG8_STAGE(PG8_SA(0, 1), a2 + hstep, voffA);
            PG8_WAIT_V(8); PG8_WAIT_L(0); PG8_BAR; PG8_MMA(0, 0, At, B0); PG8_MMA(0, 1, At, B1); PG8_BAR; PG8_SCHED;
            PG8_LDA(At, 1, 1); PG8_STAGE(PG8_SB(1, 0), b3, voffB); PG8_STAGE(PG8_SB(1, 1), b3 + hstep, voffB); PG8_STAGE(PG8_SA(1, 0), a3, voffA);
            PG8_WAIT_V(8); PG8_WAIT_L(0); PG8_BAR; PG8_MMA(1, 0, At, B0); PG8_MMA(1, 1, At, B1); PG8_BAR; PG8_SCHED;
            } else {
            PG8_LDB(B0, 0, 0); PG8_SCHED; PG8_LDA(At, 0, 0); PG8_STAGE(PG8_SA(1, 1), a1 + hstep, voffA);
            PG8_WAIT_L(8); PG8_BAR; PG8_WAIT_L(0); PG8_MMA(0, 0, At, B0); PG8_BAR; PG8_SCHED;
            PG8_LDB(B1, 0, 1); PG8_STAGE(PG8_SB(0, 0), b2, voffB);
            PG8_BAR; PG8_WAIT_L(0); PG8_MMA(0, 1, At, B1); PG8_BAR;
            PG8_LDA(At, 0, 1); PG8_STAGE(PG8_SA(0, 0), a2, voffA);
            PG8_BAR; PG8_WAIT_L(0); PG8_MMA(1, 0, At, B0); PG8_BAR; PG8_SCHED;
            PG8_STAGE(PG8_SB(0, 1), b2 + hstep, voffB);
            PG8_WAIT_V(6); PG8_BAR; PG8_MMA(1, 1, At, B1); PG8_BAR;
            PG8_LDB(B0, 1, 0); PG8_SCHED; PG8_LDA(At, 1, 0); PG8_STAGE(PG8_SA(0, 1), a2 + hstep, voffA);
            PG8_WAIT_L(8); PG8_BAR; PG8_WAIT_L(0); PG8_MMA(0, 0, At, B0); PG8_BAR; PG8_SCHED;
            PG8_LDB(B1, 1, 1); PG8_STAGE(PG8_SB(1, 0), b3, voffB);
            PG8_BAR; PG8_WAIT_L(0); PG8_MMA(0, 1, At, B1); PG8_BAR;
            PG8_LDA(At, 1, 1); PG8_STAGE(PG8_SA(1, 0), a3, voffA);
            PG8_BAR; PG8_WAIT_L(0); PG8_MMA(1, 0, At, B0); PG8_BAR; PG8_SCHED;
            PG8_STAGE(PG8_SB(1, 1), b3 + hstep, voffB);
            PG8_WAIT_V(6); PG8_BAR; PG8_MMA(1, 1, At, B1); PG8_BAR;
            }
        }
        if constexpr (ALIGN_EPI) { if (wr == 0) PG8_BAR; }
        if constexpr (!Epi::AFTER_DRAIN) { E(acc, cur, wr, wc, fr, fq); S.done(cur); }
        if (!has_next) break;
#pragma unroll
        for (int a = 0; a < 2; ++a)
#pragma unroll
            for (int b = 0; b < 2; ++b)
#pragma unroll
                for (int m = 0; m < 4; ++m)
#pragma unroll
                    for (int n = 0; n < 2; ++n) acc[a][b][m][n] = (f32x4){0.f, 0.f, 0.f, 0.f};
        cur = nxt; cA = nA; cB = nB; ++ui;
        if constexpr (ALIGN_EPI) { if (wr == 1) PG8_BAR; }
    }
    PG8_WAIT_V(0);
    if constexpr (!ALIGN_EPI) { if (wr == 0) PG8_BAR; }
    PG8_BAR;
    if constexpr (Epi::AFTER_DRAIN) { E.fused(acc, cur, wr, wc, fr, fq, lds, wid, lane); S.done(cur); }
#undef PG8_SA
#undef PG8_SB
#undef PG8_STAGE
#undef PG8_LDA
#undef PG8_LDB
#undef PG8_MMA
#undef PG8_WAIT_V
#undef PG8_WAIT_L
#undef PG8_BAR
#undef PG8_SCHED
}
}

#ifndef PG8_SP2
#define PG8_SP2 true
#endif
#ifndef PG8_ALIGN
#define PG8_ALIGN true
#endif
constexpr int NWAVES = 8;
constexpr int NB = 4, S = 4096, D = 4096, M = NB * S, DEPTH = 2;
constexpr int MEM_LEN = 256, MM = NB * MEM_LEN;
constexpr int ATTN_W = 2048, NH = 16, HD = 128, CONV_W = 1024, SSM_W = 1024, CONV_K = 31, SSM_G = 64, SSM_CH = 16, SSM_P = 64;
constexpr int MEM_W = 512, NMH = 4, DFF = 16384, IN_W = 9216;
constexpr float EPS = 1e-6f;
constexpr float QK_SCALE = 0.08838834764831845f;
constexpr size_t OW_IN = 0, OW_OUT = OW_IN + (size_t)IN_W * D, OW_CQ = OW_OUT + (size_t)D * D, OW_CKV = OW_CQ + (size_t)MEM_W * D, OW_CO = OW_CKV + (size_t)2 * MEM_W * D,
                 OW_UP = OW_CO + (size_t)D * MEM_W, OW_DOWN = OW_UP + (size_t)DFF * D, OW_GLU = OW_DOWN + (size_t)D * DFF, W_LAYER = OW_GLU + (size_t)SSM_W * SSM_W;
static_assert(W_LAYER == 198180864ull, "weight block");
constexpr size_t MiB = 1u << 20;
constexpr size_t WS_CTL = 0, CTL_ZERO_BYTES = 1 * MiB;
constexpr size_t WS_W = 1 * MiB;
constexpr size_t WS_XN = WS_W + (size_t)DEPTH * W_LAYER * 2;
constexpr size_t WS_MEMN = WS_XN + (size_t)M * D * 2;
constexpr size_t WS_KV = WS_MEMN + (size_t)DEPTH * MM * D * 2;
constexpr size_t WS_QC = WS_KV + (size_t)DEPTH * MM * 1024 * 2;
constexpr size_t WS_OC = WS_QC + (size_t)M * MEM_W * 2;
constexpr size_t WS_R = WS_OC + (size_t)M * MEM_W * 2;
constexpr size_t R_QKVC = 0;
constexpr size_t R_ATT = R_QKVC + (size_t)9 * M * 1024 * 2;
constexpr size_t R_Z = R_ATT + (size_t)3 * M * ATTN_W * 2;
constexpr size_t R_SG = R_Z + (size_t)M * SSM_W * 2;
constexpr size_t R_MIXED = R_SG + (size_t)M * SSM_W * 2;
constexpr size_t R_LSE = R_MIXED + (size_t)M * D * 2;
constexpr size_t R_PS = R_LSE + (size_t)3 * M * NH * 4;
constexpr size_t R_RS = R_PS + (size_t)64 * M * 4;
constexpr size_t R_END = R_RS + (size_t)M * 4;
constexpr size_t R_H = 0;
static_assert((size_t)M * DFF * 2 <= R_END, "h overlay");
constexpr size_t WS_END = WS_R + R_END;
constexpr size_t WS_XN2 = WS_END;
constexpr size_t WS_END2 = WS_XN2 + (size_t)M * D * 2;
constexpr size_t PSX_BYTES = (size_t)64 * M * 4, RSX_BYTES = (size_t)M * 4;
constexpr size_t WS_PSX = WS_END2, WS_RSX = WS_PSX + 3 * DEPTH * PSX_BYTES, WS_END3 = WS_RSX + 3 * DEPTH * RSX_BYTES;
static_assert(WS_XN % 256 == 0 && WS_R % 256 == 0, "alignment");
constexpr int CW_BAR = 4096;
constexpr int RING_OFF = 0, RING_BYTES = 131072;
constexpr int LDSCTL_OFF = 147456, MISC_OFF = LDSCTL_OFF + 320;
constexpr int LDS_BYTES = 163840;
constexpr int NPH_LAYER = 13, NPH = 1 + DEPTH * NPH_LAYER;

#define GAS __attribute__((address_space(1)))
#define LAS __attribute__((address_space(3)))
typedef unsigned short bf16;
typedef unsigned v4u __attribute__((ext_vector_type(4)));
typedef unsigned v2u __attribute__((ext_vector_type(2)));
typedef float f32x4 __attribute__((ext_vector_type(4)));
typedef GAS unsigned gu32;
#define LDS_WAIT() asm volatile("s_waitcnt lgkmcnt(0)" ::: "memory")
#define VM_WAIT() asm volatile("s_waitcnt vmcnt(0)" ::: "memory")
__device__ __forceinline__ unsigned f2bf(float f) { unsigned u = __builtin_bit_cast(unsigned, f); return (u + 0x7fffu + ((u >> 16) & 1u)) >> 16; }
__device__ __forceinline__ unsigned pk2(float lo, float hi) { return f2bf(lo) | (f2bf(hi) << 16); }
__device__ __forceinline__ float blo(unsigned w) { return __uint_as_float(w << 16); }
__device__ __forceinline__ float bhi(unsigned w) { return __uint_as_float(w & 0xffff0000u); }
__device__ __forceinline__ float sigm(float x) { return 1.0f / (1.0f + __expf(-x)); }

#define XB_TMO      128
#define XB_XCNT(j)  (256  + 64 * (j))
#define XB_XSUB(j)  (1280 + 64 * (j))
#define XB_XGEN(j)  (2304 + 64 * (j))
#define XB_TOP      3328
#define XB_TOPGEN   3392
#define XCD_BAR_WORDS 3456
#define XB_SPIN_CAP (1u << 18)
#ifndef XB_ACQ_SCOPE
#define XB_ACQ_SCOPE "agent"
#endif

__device__ __forceinline__ unsigned xb_ld(unsigned* p)              { return __hip_atomic_load((GAS unsigned*)p, __ATOMIC_RELAXED, __HIP_MEMORY_SCOPE_AGENT); }
__device__ __forceinline__ unsigned xb_add(unsigned* p, unsigned v) { return __hip_atomic_fetch_add((GAS unsigned*)p, v, __ATOMIC_RELAXED, __HIP_MEMORY_SCOPE_AGENT); }
__device__ __forceinline__ unsigned xb_xcc_id() { return (unsigned)__builtin_amdgcn_s_getreg((3 << 11) | 20) & 0xFu; }
#define XB_SPIN(cond, bar) do { unsigned _sp = 0; while (cond) { __builtin_amdgcn_s_sleep(1); \
    if ((++_sp & 255u) == 0u) { if (xb_ld(&(bar)[XB_TMO])) break; if (_sp > XB_SPIN_CAP) { (void)xb_add(&(bar)[XB_TMO], 1u); break; } } } } while (0)

struct XcdBarrier {
    unsigned* bar; unsigned x;
    volatile LAS unsigned* st;
};

__device__ __forceinline__ XcdBarrier xcd_barrier_post(unsigned* bar, volatile LAS unsigned* st) {
    XcdBarrier b; b.bar = bar; b.x = xb_xcc_id(); b.st = st;
    if (threadIdx.x == 0) (void)xb_add(&bar[XB_XCNT(b.x)], 1u);
    return b;
}
__device__ __forceinline__ void xcd_barrier_complete(unsigned* bar, unsigned x, unsigned& nloc, unsigned& nx) {
    const unsigned G = gridDim.x * gridDim.y * gridDim.z;
    unsigned sum, cnt, mine, sp = 0u;
    for (;;) {
        sum = 0u; cnt = 0u; mine = 0u;
#pragma unroll
        for (unsigned j = 0; j < 16; ++j) { const unsigned c = xb_ld(&bar[XB_XCNT(j)]); sum += c; cnt += (c > 0u) ? 1u : 0u; mine = (j == x) ? c : mine; }
        if (sum == G) break;
        __builtin_amdgcn_s_sleep(1);
        if ((++sp & 255u) == 0u) { if (xb_ld(&bar[XB_TMO])) break; if (sp > XB_SPIN_CAP) { (void)xb_add(&bar[XB_TMO], 1u); break; } }
    }
    nloc = mine > 0u ? mine : 1u; nx = cnt > 0u ? cnt : 1u;
}

__device__ __forceinline__ void xcd_barrier(const XcdBarrier& b) {
    asm volatile("s_waitcnt vmcnt(0)" ::: "memory");
    __syncthreads();
    if (threadIdx.x == 0) {
        unsigned* bar = b.bar;
        __builtin_amdgcn_s_waitcnt(0);
        unsigned nloc = b.st[0], nx = b.st[1];
        if (nloc == 0u) { xcd_barrier_complete(bar, b.x, nloc, nx); b.st[0] = nloc; b.st[1] = nx; }
        const unsigned old = xb_add(&bar[XB_XSUB(b.x)], 1u);
        const unsigned gen = old / nloc;
        if (old + 1u == (gen + 1u) * nloc) {
            __builtin_amdgcn_fence(__ATOMIC_RELEASE, "agent");
            asm volatile("s_waitcnt vmcnt(0)" ::: "memory");
            const unsigned og = xb_add(&bar[XB_TOP], 1u);
            const unsigned tg = og / nx;
            if (og + 1u == (tg + 1u) * nx) xb_add(&bar[XB_TOPGEN], 1u);
            else XB_SPIN(xb_ld(&bar[XB_TOPGEN]) == tg, bar);
            __builtin_amdgcn_fence(__ATOMIC_ACQUIRE, XB_ACQ_SCOPE);
            xb_add(&bar[XB_XGEN(b.x)], 1u);
            asm volatile("s_waitcnt vmcnt(0)" ::: "memory");
        } else {
            XB_SPIN(xb_ld(&bar[XB_XGEN(b.x)]) == gen, bar);
            __builtin_amdgcn_fence(__ATOMIC_ACQUIRE, XB_ACQ_SCOPE);
            asm volatile("s_waitcnt vmcnt(0)" ::: "memory");
        }
    }
    __syncthreads();
}

#define SWZ_XOR(v, m) __builtin_bit_cast(float, __builtin_amdgcn_ds_swizzle(__builtin_bit_cast(int, (v)), ((m) << 10) | 0x1f))
__device__ __forceinline__ float xor32_sum(float v) { const auto r = __builtin_amdgcn_permlane32_swap(__builtin_bit_cast(unsigned, v), __builtin_bit_cast(unsigned, v), false, false); return __builtin_bit_cast(float, r[0]) + __builtin_bit_cast(float, r[1]); }
__device__ __forceinline__ float xor32_max(float v) { const auto r = __builtin_amdgcn_permlane32_swap(__builtin_bit_cast(unsigned, v), __builtin_bit_cast(unsigned, v), false, false); return fmaxf(__builtin_bit_cast(float, r[0]), __builtin_bit_cast(float, r[1])); }
__device__ __forceinline__ int opq_lane_id() { int l = (int)__builtin_amdgcn_mbcnt_hi(~0u, __builtin_amdgcn_mbcnt_lo(~0u, 0u)); asm volatile("" : "+v"(l)); return l; }
__device__ __forceinline__ float bperm_xor(float v, int l, int m) { return __builtin_bit_cast(float, __builtin_amdgcn_ds_bpermute((l ^ m) << 2, __builtin_bit_cast(int, v))); }
__device__ __forceinline__ float wave_sum(float v) {
    const int l = opq_lane_id();
#pragma unroll
    for (int o = 1; o < 64; o <<= 1) v += bperm_xor(v, l, o);
    return v;
}
__device__ __forceinline__ float wave_max(float v) {
    const int l = opq_lane_id();
#pragma unroll
    for (int o = 1; o < 64; o <<= 1) v = fmaxf(v, bperm_xor(v, l, o));
    return v;
}
#define X32SUM(v) ((v) + bperm_xor((v), opq_lane_id(), 32))
#define X32MAX(v) fmaxf((v), bperm_xor((v), opq_lane_id(), 32))
__device__ __forceinline__ void p0_transpose_item(const float* W, int K, int N, bf16* WT, int row_off, LAS float* scr, int item, int lane) {
    const int nblk = N / 32, kb = item / nblk, nb = item % nblk, k0 = 64 * kb, n0 = 32 * nb;
#pragma unroll 8
    for (int i = 0; i < 32; ++i) { const int kk = 2 * i + (lane >> 5); scr[kk * 33 + (lane & 31)] = W[(size_t)(k0 + kk) * N + n0 + (lane & 31)]; }
    LDS_WAIT(); asm volatile("" ::: "memory");
    const int c = lane & 7;
#pragma unroll
    for (int j = 0; j < 4; ++j) { const int n = (lane >> 3) + 8 * j; const LAS float* s = scr + (8 * c) * 33 + n;
        v4u o; o.x = pk2(s[0 * 33], s[1 * 33]); o.y = pk2(s[2 * 33], s[3 * 33]); o.z = pk2(s[4 * 33], s[5 * 33]); o.w = pk2(s[6 * 33], s[7 * 33]);
        *(GAS v4u*)(WT + (size_t)(row_off + n0 + n) * K + k0 + 8 * c) = o; }
    LDS_WAIT(); asm volatile("" ::: "memory");
}
__device__ __forceinline__ void rmsnorm_rows(const float* x, const float* g, bf16* out, int rows, int gw, int NGW, int lane) {
    for (int m = gw; m < rows; m += NGW) {
        const GAS f32x4* xr = (const GAS f32x4*)(x + (size_t)m * D) + lane;
        f32x4 v[16]; float s = 0.f;
#pragma unroll
        for (int j = 0; j < 16; ++j) { v[j] = xr[64 * j]; s += (v[j].x * v[j].x + v[j].y * v[j].y) + (v[j].z * v[j].z + v[j].w * v[j].w); }
        const float r = 1.0f / sqrtf(wave_sum(s) * (1.f / D) + EPS);
        const GAS f32x4* g4 = (const GAS f32x4*)g + lane;
        GAS unsigned long long* o8 = (GAS unsigned long long*)(out + (size_t)m * D) + lane;
#pragma unroll
        for (int j = 0; j < 16; ++j) { const f32x4 gg = g4[64 * j];
            o8[64 * j] = (unsigned long long)pk2(v[j].x * r * gg.x, v[j].y * r * gg.y) | ((unsigned long long)pk2(v[j].z * r * gg.z, v[j].w * r * gg.w) << 32); }
    }
}

__device__ __forceinline__ void xb_rows(const float* x, bf16* xb, float* rs, int gw, int NGW, int lane) {
    const int rpw = (M + NGW - 1) / NGW;
    for (int m = gw * rpw; m < M && m < (gw + 1) * rpw; ++m) {
        const GAS f32x4* xr = (const GAS f32x4*)(x + (size_t)m * D) + lane; GAS unsigned long long* o8 = (GAS unsigned long long*)(xb + (size_t)m * D) + lane; float s = 0.f;
#pragma unroll
        for (int j = 0; j < 16; ++j) { const f32x4 v = xr[64 * j]; s += (v.x * v.x + v.y * v.y) + (v.z * v.z + v.w * v.w);
            o8[64 * j] = (unsigned long long)pk2(v.x, v.y) | ((unsigned long long)pk2(v.z, v.w) << 32); }
        s = wave_sum(s);
        if (lane == 0) ((GAS float*)rs)[m] = 1.0f / sqrtf(s * (1.f / D) + EPS);
    }
}
__device__ __forceinline__ void reduce_rows8(const float* ps, float* rs, int gw, int NGW) {
    const int lane = opq_lane_id(), rsub = lane >> 3, part = lane & 7;
    for (int r0 = gw * 8; r0 < M; r0 += NGW * 8) { const int row = r0 + rsub; float v[8];
#pragma unroll
        for (int j = 0; j < 8; ++j) v[j] = ((const GAS float*)ps)[(size_t)(8 * part + j) * M + row];
        float s = ((v[0] + v[1]) + (v[2] + v[3])) + ((v[4] + v[5]) + (v[6] + v[7]));
        s += bperm_xor(s, lane, 1); s += bperm_xor(s, lane, 2); s += bperm_xor(s, lane, 4);
        if (part == 0) ((GAS float*)rs)[row] = 1.0f / sqrtf(s * (1.f / D) + EPS); }
}
__device__ __forceinline__ void reduce_rows(const float* ps, float* rs, int gw, int NGW, int lane) {
    for (int row = gw * 64 + lane; row < M; row += NGW * 64) { float s = 0.f;
#pragma unroll 8
        for (int j = 0; j < 64; ++j) s += ((const GAS float*)ps)[(size_t)j * M + row];
        ((GAS float*)rs)[row] = 1.0f / sqrtf(s * (1.f / D) + EPS); }
}

__device__ __forceinline__ void reduce_rows_wg(const float* ps, float* rs, int r0, int tid, LAS float* sc) {
    const int row = r0 + (tid & 255), part = tid >> 8; float s = 0.f;
#pragma unroll 8
    for (int j = 0; j < 32; ++j) s += ((const GAS float*)ps)[(size_t)(32 * part + j) * M + row];
    if (part == 1) sc[tid & 255] = s;
    LDS_WAIT(); __syncthreads();
    if (part == 0) ((GAS float*)rs)[row] = 1.0f / sqrtf((s + sc[tid & 255]) * (1.f / D) + EPS);
    VM_WAIT(); __syncthreads();
}

template <int MODE> __device__ __forceinline__ size_t attn_keyoff(int r, int j, int b, int ts, int h, bool& valid) {
    if (MODE == 0) {
        int tk; if (r < 6) { const int d = 1 << (2 * (r >> 1)); const int dist = 1 + 64 * (r & 1) + j; tk = ts - dist * d; valid = tk >= 0; } else { tk = ts; valid = j < 3; }
        if (!valid) tk = ts;
        return (size_t)(h >> 3) * M * 1024 + (size_t)(b * S + tk) * 1024 + (h & 7) * 128;
    } else { valid = true; return (size_t)(b * MEM_LEN + 64 * r + j) * 1024 + h * 128; }
}
template <int MODE> __device__ __forceinline__ void attn_naive_item(int item, const bf16* Qb, const bf16* Kb, const bf16* Vb, const float* gq, const float* gk, bf16* Ob, LAS float* qn, int lane) {
    constexpr int NR = MODE == 0 ? 7 : 4;
    const int t = item & (M - 1), h = item >> 14, b = t >> 12, ts = t & (S - 1);
    const size_t qoff = MODE == 0 ? (size_t)(h >> 3) * M * 1024 + (size_t)t * 1024 + (h & 7) * 128 : (size_t)t * MEM_W + h * 128;
    const size_t ooff = MODE == 0 ? (size_t)t * ATTN_W + h * 128 : (size_t)t * MEM_W + h * 128;
    {
        const unsigned qw = *(const GAS unsigned*)(Qb + qoff + 2 * lane);
        const float q0 = blo(qw), q1 = bhi(qw);
        const float rq = 1.0f / sqrtf(wave_sum(q0 * q0 + q1 * q1) * (1.f / HD) + EPS);
        qn[2 * lane] = q0 * rq * gq[2 * lane] * gk[2 * lane] * QK_SCALE; qn[2 * lane + 1] = q1 * rq * gq[2 * lane + 1] * gk[2 * lane + 1] * QK_SCALE;
        LDS_WAIT();
    }
    const LAS f32x4* qn4 = (const LAS f32x4*)qn;
    float sc[NR];
#pragma unroll
    for (int r = 0; r < NR; ++r) {
        bool valid; const size_t off = attn_keyoff<MODE>(r, lane, b, ts, h, valid);
        const GAS v4u* kp = (const GAS v4u*)(Kb + off);
        float dot = 0.f, ss = 0.f;
#pragma unroll
        for (int c = 0; c < 16; ++c) { const v4u kk = kp[c]; const f32x4 qa = qn4[2 * c], qb = qn4[2 * c + 1];
            const float k0 = blo(kk.x), k1 = bhi(kk.x), k2 = blo(kk.y), k3 = bhi(kk.y), k4 = blo(kk.z), k5 = bhi(kk.z), k6 = blo(kk.w), k7 = bhi(kk.w);
            dot += (k0 * qa.x + k1 * qa.y) + (k2 * qa.z + k3 * qa.w) + (k4 * qb.x + k5 * qb.y) + (k6 * qb.z + k7 * qb.w);
            ss += (k0 * k0 + k1 * k1) + (k2 * k2 + k3 * k3) + (k4 * k4 + k5 * k5) + (k6 * k6 + k7 * k7); }
        sc[r] = valid ? dot * (1.0f / sqrtf(ss * (1.f / HD) + EPS)) : -1e30f;
    }
    float mx = sc[0];
#pragma unroll
    for (int r = 1; r < NR; ++r) mx = fmaxf(mx, sc[r]);
    mx = wave_max(mx);
    float p[NR]; float ls = 0.f;
#pragma unroll
    for (int r = 0; r < NR; ++r) { p[r] = __expf(sc[r] - mx); ls += p[r]; }
    const float inv = 1.0f / wave_sum(ls);
    const int g4 = lane >> 4, li = lane & 15;
    float acc[8];
#pragma unroll
    for (int k = 0; k < 8; ++k) acc[k] = 0.f;
#pragma unroll
    for (int r = 0; r < NR; ++r) {
#pragma unroll 4
        for (int i = 0; i < 16; ++i) { const int j = 4 * i + g4; const float pj = __shfl(p[r], j);
            bool valid; const size_t off = attn_keyoff<MODE>(r, j, b, ts, h, valid);
            const v4u vv = *(const GAS v4u*)(Vb + off + 8 * li);
            acc[0] += pj * blo(vv.x); acc[1] += pj * bhi(vv.x); acc[2] += pj * blo(vv.y); acc[3] += pj * bhi(vv.y);
            acc[4] += pj * blo(vv.z); acc[5] += pj * bhi(vv.z); acc[6] += pj * blo(vv.w); acc[7] += pj * bhi(vv.w); }
    }
#pragma unroll
    for (int k = 0; k < 8; ++k) { acc[k] += __shfl_xor(acc[k], 16); acc[k] += __shfl_xor(acc[k], 32); acc[k] *= inv; }
    if (g4 == 0) { v4u o; o.x = pk2(acc[0], acc[1]); o.y = pk2(acc[2], acc[3]); o.z = pk2(acc[4], acc[5]); o.w = pk2(acc[6], acc[7]); *(GAS v4u*)(Ob + ooff + 8 * li) = o; }
    LDS_WAIT();
}

typedef short bf16x8v __attribute__((ext_vector_type(8)));
typedef float f32x16 __attribute__((ext_vector_type(16)));
typedef short s16x4v __attribute__((ext_vector_type(4)));
typedef float f32x2v __attribute__((ext_vector_type(2)));
typedef __bf16 bf16x2v __attribute__((ext_vector_type(2)));
__device__ __forceinline__ unsigned cvtpk(float lo, float hi) { f32x2v v = {lo, hi}; bf16x2v b = __builtin_convertvector(v, bf16x2v); return __builtin_bit_cast(unsigned, b); }
__device__ __forceinline__ unsigned vt_off(unsigned row, unsigned ch) { return 256u * row + 16u * (ch ^ (((row & 3u) << 2) | ((row >> 2) & 3u))); }
__device__ __forceinline__ s16x4v vtr(const LAS unsigned char* p) { return __builtin_bit_cast(s16x4v, __builtin_amdgcn_ds_read_tr16_b64_v4i16((LAS s16x4v*)p)); }
__device__ __forceinline__ float sumsq8(v4u w) { const float a0 = blo(w.x), a1 = bhi(w.x), a2 = blo(w.y), a3 = bhi(w.y), a4 = blo(w.z), a5 = bhi(w.z), a6 = blo(w.w), a7 = bhi(w.w);
    return ((a0 * a0 + a1 * a1) + (a2 * a2 + a3 * a3)) + ((a4 * a4 + a5 * a5) + (a6 * a6 + a7 * a7)); }
constexpr float LOG2E = 1.4426950408889634f;
template <int MODE> __device__ __forceinline__ void attn_mfma_item(int item, const bf16* Qb, const bf16* Kb, const bf16* Vb, bf16* Ob, float* LSE, const LAS float* G2, LAS unsigned char* wl, int lane) {
    const int rr = lane & 31, hh = lane >> 5;
    int h, b, d = 1, r = 0, qt, pat = 0;
    if (MODE == 0) { const int j = item & 127; b = (item >> 7) & 3; h = (item >> 9) & 15; pat = item >> 13; d = 1 << (2 * pat); const int per = 128 >> (2 * pat); r = j / per; qt = j - r * per; }
    else { const int tt = item & 511; h = item >> 9; b = tt >> 7; qt = tt & 127; }
    const size_t hso = MODE == 0 ? (size_t)(h >> 3) * M * 1024 + (h & 7) * 128 + 64 * hh : (size_t)h * 128 + 64 * hh;
    const int qtok = MODE == 0 ? b * S + (32 * qt + rr) * d + r : b * S + 32 * qt + rr;
    bf16x8v Qf[8];
    {   const GAS v4u* qp = (const GAS v4u*)(Qb + (MODE == 0 ? (size_t)qtok * 1024 : (size_t)qtok * MEM_W) + hso);
        v4u qraw[8]; float ss = 0.f;
#pragma unroll
        for (int ks = 0; ks < 8; ++ks) { qraw[ks] = qp[ks]; ss += sumsq8(qraw[ks]); }
        ss = X32SUM(ss);
        const float rq = 1.0f / sqrtf(ss * (1.f / HD) + EPS);
        const LAS f32x4* g4 = (const LAS f32x4*)(G2 + 64 * hh);
#pragma unroll
        for (int ks = 0; ks < 8; ++ks) { const f32x4 ga = g4[2 * ks], gb = g4[2 * ks + 1]; const v4u w = qraw[ks]; v4u o;
            o.x = cvtpk(blo(w.x) * rq * ga.x, bhi(w.x) * rq * ga.y); o.y = cvtpk(blo(w.y) * rq * ga.z, bhi(w.y) * rq * ga.w);
            o.z = cvtpk(blo(w.z) * rq * gb.x, bhi(w.z) * rq * gb.y); o.w = cvtpk(blo(w.w) * rq * gb.z, bhi(w.w) * rq * gb.w);
            Qf[ks] = __builtin_bit_cast(bf16x8v, o); }
    }
    f32x16 O0, O1, O2, O3;
#pragma unroll
    for (int i = 0; i < 16; ++i) { O0[i] = 0.f; O1[i] = 0.f; O2[i] = 0.f; O3[i] = 0.f; }
    float mrun = -1e30f, lrun = 0.f;
    LAS float* RK = (LAS float*)(wl + 8192);
    const unsigned q_ = (lane & 15) >> 2, p_ = lane & 3, blk = (lane >> 4) & 1;
    const int kt_lo = MODE == 0 ? (qt < 4 ? 4 - qt : 0) : 0, kt_hi = MODE == 0 ? 4 : 7;
#define ATT_KTOK(kt_) (MODE == 0 ? b * S + (32 * qt - 128 + 32 * (kt_) + rr) * d + r : b * MEM_LEN + 32 * (kt_) + rr)
    v4u kraw[8], vraw[8];
    {   const int ktok = ATT_KTOK(kt_lo);
        const GAS v4u* kp = (const GAS v4u*)(Kb + (size_t)ktok * 1024 + hso); const GAS v4u* vp = (const GAS v4u*)(Vb + (size_t)ktok * 1024 + hso);
#pragma unroll
        for (int ks = 0; ks < 8; ++ks) kraw[ks] = kp[ks];
#if ATT_PREFETCH != 2
#pragma unroll
        for (int ks = 0; ks < 8; ++ks) vraw[ks] = vp[ks];
#else
        (void)vp;
#endif
    }
    for (int kt = kt_lo; kt <= kt_hi; ++kt) {
#if ATT_PREFETCH == 2
        {   const GAS v4u* vp = (const GAS v4u*)(Vb + (size_t)ATT_KTOK(kt) * 1024 + hso);
#pragma unroll
            for (int ks = 0; ks < 8; ++ks) vraw[ks] = vp[ks]; }
#endif
#if !ATT_PREFETCH
        if (kt > kt_lo) { const int ktok = ATT_KTOK(kt);
            const GAS v4u* kp = (const GAS v4u*)(Kb + (size_t)ktok * 1024 + hso); const GAS v4u* vp = (const GAS v4u*)(Vb + (size_t)ktok * 1024 + hso);
#pragma unroll
            for (int ks = 0; ks < 8; ++ks) kraw[ks] = kp[ks];
#pragma unroll
            for (int ks = 0; ks < 8; ++ks) vraw[ks] = vp[ks]; }
#endif
        float ss = 0.f;
#pragma unroll
        for (int ks = 0; ks < 8; ++ks) ss += sumsq8(kraw[ks]);
        ss = X32SUM(ss);
        const float rk = 1.0f / sqrtf(ss * (1.f / HD) + EPS);
        if (hh == 0) RK[rr] = rk;
        f32x16 sacc;
#pragma unroll
        for (int i = 0; i < 16; ++i) sacc[i] = 0.f;
#pragma unroll
        for (int ks = 0; ks < 8; ++ks) sacc = __builtin_amdgcn_mfma_f32_32x32x16_bf16(__builtin_bit_cast(bf16x8v, kraw[ks]), Qf[ks], sacc, 0, 0, 0);
#if ATT_PREFETCH == 2
        if (kt < kt_hi) { const GAS v4u* kp = (const GAS v4u*)(Kb + (size_t)ATT_KTOK(kt + 1) * 1024 + hso);
#pragma unroll
            for (int ks = 0; ks < 8; ++ks) kraw[ks] = kp[ks]; }
#endif
#pragma unroll
        for (int ks = 0; ks < 8; ++ks) *(LAS v4u*)(wl + vt_off((unsigned)rr, (unsigned)(8 * hh + ks))) = vraw[ks];
        if (ATT_PREFETCH == 1 && kt < kt_hi) { const int ktok = ATT_KTOK(kt + 1);
            const GAS v4u* kp = (const GAS v4u*)(Kb + (size_t)ktok * 1024 + hso); const GAS v4u* vp = (const GAS v4u*)(Vb + (size_t)ktok * 1024 + hso);
#pragma unroll
            for (int ks = 0; ks < 8; ++ks) kraw[ks] = kp[ks];
#pragma unroll
            for (int ks = 0; ks < 8; ++ks) vraw[ks] = vp[ks]; }
        LDS_WAIT();
        float sv[16];
#pragma unroll
        for (int g = 0; g < 4; ++g) { const f32x4 r4 = *(const LAS f32x4*)(RK + 8 * g + 4 * hh);
            sv[4 * g + 0] = sacc[4 * g + 0] * r4.x; sv[4 * g + 1] = sacc[4 * g + 1] * r4.y; sv[4 * g + 2] = sacc[4 * g + 2] * r4.z; sv[4 * g + 3] = sacc[4 * g + 3] * r4.w; }
        if (MODE == 0) {
            if (kt == 0) {
#pragma unroll
                for (int i = 0; i < 16; ++i) { const int kk = (i & 3) + 8 * (i >> 2) + 4 * hh; sv[i] = (kk >= rr) ? sv[i] : -1e30f; } }
            if (kt == 4) {
#pragma unroll
                for (int i = 0; i < 16; ++i) { const int kk = (i & 3) + 8 * (i >> 2) + 4 * hh; sv[i] = (kk <= rr) ? sv[i] : -1e30f; } }
        }
        float mt = sv[0];
#pragma unroll
        for (int i = 1; i < 16; ++i) mt = fmaxf(mt, sv[i]);
        mt = X32MAX(mt);
        const float mn = fmaxf(mrun, mt), alpha = __builtin_amdgcn_exp2f(mrun - mn); mrun = mn;
        float ps = 0.f;
#pragma unroll
        for (int i = 0; i < 16; ++i) { sv[i] = __builtin_amdgcn_exp2f(sv[i] - mn); ps += sv[i]; }
        ps = X32SUM(ps);
        lrun = lrun * alpha + ps;
#pragma unroll
        for (int i = 0; i < 16; ++i) { O0[i] *= alpha; O1[i] *= alpha; O2[i] *= alpha; O3[i] *= alpha; }
        v4u pw0, pw1;
        pw0.x = cvtpk(sv[0], sv[1]); pw0.y = cvtpk(sv[2], sv[3]); pw0.z = cvtpk(sv[4], sv[5]); pw0.w = cvtpk(sv[6], sv[7]);
        pw1.x = cvtpk(sv[8], sv[9]); pw1.y = cvtpk(sv[10], sv[11]); pw1.z = cvtpk(sv[12], sv[13]); pw1.w = cvtpk(sv[14], sv[15]);
        const bf16x8v P0 = __builtin_bit_cast(bf16x8v, pw0), P1 = __builtin_bit_cast(bf16x8v, pw1);
#define ATT_VFRAG(c, s) ({ const s16x4v lo_ = vtr(wl + vt_off(16u * (s) + 4u * hh + q_, 4u * (c) + 2u * blk + (p_ >> 1)) + 8u * (p_ & 1u)); \
                           const s16x4v hi_ = vtr(wl + vt_off(16u * (s) + 8u + 4u * hh + q_, 4u * (c) + 2u * blk + (p_ >> 1)) + 8u * (p_ & 1u)); \
                           (bf16x8v){lo_[0], lo_[1], lo_[2], lo_[3], hi_[0], hi_[1], hi_[2], hi_[3]}; })
        O0 = __builtin_amdgcn_mfma_f32_32x32x16_bf16(ATT_VFRAG(0, 0), P0, O0, 0, 0, 0); O0 = __builtin_amdgcn_mfma_f32_32x32x16_bf16(ATT_VFRAG(0, 1), P1, O0, 0, 0, 0);
        O1 = __builtin_amdgcn_mfma_f32_32x32x16_bf16(ATT_VFRAG(1, 0), P0, O1, 0, 0, 0); O1 = __builtin_amdgcn_mfma_f32_32x32x16_bf16(ATT_VFRAG(1, 1), P1, O1, 0, 0, 0);
        O2 = __builtin_amdgcn_mfma_f32_32x32x16_bf16(ATT_VFRAG(2, 0), P0, O2, 0, 0, 0); O2 = __builtin_amdgcn_mfma_f32_32x32x16_bf16(ATT_VFRAG(2, 1), P1, O2, 0, 0, 0);
        O3 = __builtin_amdgcn_mfma_f32_32x32x16_bf16(ATT_VFRAG(3, 0), P0, O3, 0, 0, 0); O3 = __builtin_amdgcn_mfma_f32_32x32x16_bf16(ATT_VFRAG(3, 1), P1, O3, 0, 0, 0);
#undef ATT_VFRAG
        LDS_WAIT();
    }
#undef ATT_KTOK
    const float inv = 1.0f / lrun;
    bf16* orow = MODE == 0 ? Ob + (size_t)pat * M * ATTN_W + (size_t)qtok * ATTN_W + h * 128 : Ob + (size_t)qtok * MEM_W + h * 128;
#pragma unroll
    for (int g = 0; g < 4; ++g) {
        v2u w;
        w.x = cvtpk(O0[4 * g] * inv, O0[4 * g + 1] * inv); w.y = cvtpk(O0[4 * g + 2] * inv, O0[4 * g + 3] * inv); *(GAS v2u*)(orow + 0 + 8 * g + 4 * hh) = w;
        w.x = cvtpk(O1[4 * g] * inv, O1[4 * g + 1] * inv); w.y = cvtpk(O1[4 * g + 2] * inv, O1[4 * g + 3] * inv); *(GAS v2u*)(orow + 32 + 8 * g + 4 * hh) = w;
        w.x = cvtpk(O2[4 * g] * inv, O2[4 * g + 1] * inv); w.y = cvtpk(O2[4 * g + 2] * inv, O2[4 * g + 3] * inv); *(GAS v2u*)(orow + 64 + 8 * g + 4 * hh) = w;
        w.x = cvtpk(O3[4 * g] * inv, O3[4 * g + 1] * inv); w.y = cvtpk(O3[4 * g + 2] * inv, O3[4 * g + 3] * inv); *(GAS v2u*)(orow + 96 + 8 * g + 4 * hh) = w;
    }
    if (MODE == 0 && hh == 0) ((GAS float*)LSE)[(((size_t)pat * NB + b) * NH + h) * S + r * (S / d) + 32 * qt + rr] = mrun + __builtin_amdgcn_logf(lrun);
}

typedef __amdgpu_buffer_rsrc_t brsrc_t;
__device__ __forceinline__ brsrc_t mk_rsrc(const void* base, unsigned bytes) { return __builtin_amdgcn_make_buffer_rsrc((void*)base, 0, (int)bytes, 0x00020000); }
__device__ __forceinline__ v4u bload(brsrc_t rs, unsigned voff, unsigned soff) { return __builtin_bit_cast(v4u, __builtin_amdgcn_raw_buffer_load_b128(rs, (int)voff, (int)soff, 0)); }
__device__ __forceinline__ void bstore(brsrc_t rs, unsigned voff, unsigned soff, v4u v) { __builtin_amdgcn_raw_buffer_store_b128(__builtin_bit_cast(__attribute__((ext_vector_type(4))) unsigned, v), rs, (int)voff, (int)soff, 0); }
constexpr int KTP = 272;
__device__ __forceinline__ float sumsq8d(v4u w) {
    float s = __builtin_amdgcn_fdot2_f32_bf16(__builtin_bit_cast(bf16x2v, w.x), __builtin_bit_cast(bf16x2v, w.x), 0.0f, false);
    s = __builtin_amdgcn_fdot2_f32_bf16(__builtin_bit_cast(bf16x2v, w.y), __builtin_bit_cast(bf16x2v, w.y), s, false);
    s = __builtin_amdgcn_fdot2_f32_bf16(__builtin_bit_cast(bf16x2v, w.z), __builtin_bit_cast(bf16x2v, w.z), s, false);
    return __builtin_amdgcn_fdot2_f32_bf16(__builtin_bit_cast(bf16x2v, w.w), __builtin_bit_cast(bf16x2v, w.w), s, false); }
__device__ __forceinline__ float sumsq64d(const v4u (&w)[8]) {
    float a0 = 0.f, a1 = 0.f, a2 = 0.f, a3 = 0.f;
#pragma unroll
    for (int k = 0; k < 8; ++k) {
        a0 = __builtin_amdgcn_fdot2_f32_bf16(__builtin_bit_cast(bf16x2v, w[k].x), __builtin_bit_cast(bf16x2v, w[k].x), a0, false);
        a1 = __builtin_amdgcn_fdot2_f32_bf16(__builtin_bit_cast(bf16x2v, w[k].y), __builtin_bit_cast(bf16x2v, w[k].y), a1, false);
        a2 = __builtin_amdgcn_fdot2_f32_bf16(__builtin_bit_cast(bf16x2v, w[k].z), __builtin_bit_cast(bf16x2v, w[k].z), a2, false);
        a3 = __builtin_amdgcn_fdot2_f32_bf16(__builtin_bit_cast(bf16x2v, w[k].w), __builtin_bit_cast(bf16x2v, w[k].w), a3, false); }
    return (a0 + a1) + (a2 + a3);
}
template <int MODE> __device__ __forceinline__ void attn_mfma_item2(int item, brsrc_t rsQ, brsrc_t rsK, brsrc_t rsV, brsrc_t rsO, float* LSE, const LAS float* G2, LAS unsigned char* wl, int lane) {
    const int rr = lane & 31, hh = lane >> 5;
    const int cr = lane >> 4, cc = lane & 15;
    int h, b, d = 1, r = 0, qt, pat = 0;
    if (MODE == 0) { const int j = item & 127; b = (item >> 7) & 3; h = (item >> 9) & 15; pat = item >> 13; d = 1 << (2 * pat); const int per = 128 >> (2 * pat); r = j / per; qt = j - r * per; }
    else { const int tt = item & 511; h = item >> 9; b = tt >> 7; qt = tt & 127; }
    LAS unsigned char* KB = wl; LAS unsigned char* VB = wl + 8704; LAS float* RK = (LAS float*)(wl + 16896);
    const unsigned kpitch = 2048u, qpitch = MODE == 0 ? 2048u : 2u * MEM_W, opitch = MODE == 0 ? 2u * ATTN_W : 2u * MEM_W;
    const unsigned hsK = MODE == 0 ? (unsigned)(h >> 3) * (unsigned)(M * 1024 * 2) + (unsigned)(h & 7) * 256u : (unsigned)h * 256u;
    const unsigned hsO = MODE == 0 ? (unsigned)pat * (unsigned)(M * ATTN_W * 2) + (unsigned)h * 256u : (unsigned)h * 256u;
    const unsigned lK = (unsigned)(cr * d) * kpitch + 16u * cc, lQ = (unsigned)(cr * d) * qpitch + 16u * cc, lO = (unsigned)(cr * d) * opitch + 16u * cc;
    const int qtok0 = MODE == 0 ? b * S + (32 * qt) * d + r : b * S + 32 * qt;
    const int ktokb = MODE == 0 ? b * S + (32 * qt - 128) * d + r : b * MEM_LEN;
    const unsigned wK = (unsigned)(KTP * cr + 16 * cc), rK = (unsigned)(KTP * rr + 128 * hh);
    bf16x8v Qf[8];
    {   v4u st[8];
#pragma unroll
        for (int i = 0; i < 8; ++i) st[i] = bload(rsQ, lQ, hsK + (unsigned)(qtok0 + 4 * i * d) * qpitch);
#pragma unroll
        for (int i = 0; i < 8; ++i) *(LAS v4u*)(KB + wK + 4 * KTP * i) = st[i];
        LDS_WAIT();
        v4u qraw[8]; float ss;
#pragma unroll
        for (int ks = 0; ks < 8; ++ks) qraw[ks] = *(const LAS v4u*)(KB + rK + 16 * ks);
        LDS_WAIT();
        ss = 0.f;
#pragma unroll
        for (int ks = 0; ks < 8; ++ks) ss += sumsq8(qraw[ks]);
        ss = X32SUM(ss);
        const float rq = 1.0f / sqrtf(ss * (1.f / HD) + EPS);
        const LAS f32x4* g4 = (const LAS f32x4*)(G2 + 64 * hh);
#pragma unroll
        for (int ks = 0; ks < 8; ++ks) { const f32x4 ga = g4[2 * ks], gb = g4[2 * ks + 1]; const v4u w = qraw[ks]; v4u o;
            o.x = cvtpk(blo(w.x) * rq * ga.x, bhi(w.x) * rq * ga.y); o.y = cvtpk(blo(w.y) * rq * ga.z, bhi(w.y) * rq * ga.w);
            o.z = cvtpk(blo(w.z) * rq * gb.x, bhi(w.z) * rq * gb.y); o.w = cvtpk(blo(w.w) * rq * gb.z, bhi(w.w) * rq * gb.w);
            Qf[ks] = __builtin_bit_cast(bf16x8v, o); }
    }
    f32x16 O0, O1, O2, O3;
#pragma unroll
    for (int i = 0; i < 16; ++i) { O0[i] = 0.f; O1[i] = 0.f; O2[i] = 0.f; O3[i] = 0.f; }
    float mrun = -1e30f, lrun = 0.f;
    const unsigned q_ = (lane & 15) >> 2, p_ = lane & 3, blk = (lane >> 4) & 1;
    unsigned wV[4];
#pragma unroll
    for (int m = 0; m < 4; ++m) wV[m] = 256u * cr + 16u * ((unsigned)cc ^ ((unsigned)(cr << 2) | (unsigned)m));
    const int kt_lo = MODE == 0 ? (qt < 4 ? 4 - qt : 0) : 0, kt_hi = MODE == 0 ? 4 : 7;
    v4u kst[8], vst[8];
#pragma unroll
    for (int i = 0; i < 8; ++i) kst[i] = bload(rsK, lK, hsK + (unsigned)(ktokb + (32 * kt_lo + 4 * i) * d) * kpitch);
#pragma unroll
    for (int i = 0; i < 8; ++i) vst[i] = bload(rsV, lK, hsK + (unsigned)(ktokb + (32 * kt_lo + 4 * i) * d) * kpitch);
    for (int kt = kt_lo; kt <= kt_hi; ++kt) {
#pragma unroll
        for (int i = 0; i < 8; ++i) *(LAS v4u*)(KB + wK + 4 * KTP * i) = kst[i];
#if ATT_EARLY_PF
#pragma unroll
        for (int i = 0; i < 8; ++i) *(LAS v4u*)(VB + wV[i & 3] + 1024 * i) = vst[i];
        if (kt < kt_hi) {
#pragma unroll
            for (int i = 0; i < 8; ++i) kst[i] = bload(rsK, lK, hsK + (unsigned)(ktokb + (32 * (kt + 1) + 4 * i) * d) * kpitch);
#pragma unroll
            for (int i = 0; i < 8; ++i) vst[i] = bload(rsV, lK, hsK + (unsigned)(ktokb + (32 * (kt + 1) + 4 * i) * d) * kpitch); }
#endif
        LDS_WAIT();
        v4u kraw[8];
#pragma unroll
        for (int ks = 0; ks < 8; ++ks) kraw[ks] = *(const LAS v4u*)(KB + rK + 16 * ks);
        f32x16 sacc;
#if ATT_GRAM
        {   f32x16 gacc;
#pragma unroll
            for (int i = 0; i < 16; ++i) gacc[i] = 0.f;
#pragma unroll
            for (int ks = 0; ks < 8; ++ks) gacc = __builtin_amdgcn_mfma_f32_32x32x16_bf16(__builtin_bit_cast(bf16x8v, kraw[ks]), __builtin_bit_cast(bf16x8v, kraw[ks]), gacc, 0, 0, 0);
            unsigned m0 = (unsigned)(((int)((unsigned)rr << 31)) >> 31), m1 = (unsigned)(((int)((unsigned)rr << 30)) >> 31), m2 = (unsigned)(((int)((unsigned)rr << 28)) >> 31), m3 = (unsigned)(((int)((unsigned)rr << 27)) >> 31);
            asm volatile("" : "+v"(m0), "+v"(m1), "+v"(m2), "+v"(m3));
#define ATT_BSEL(m, a, b) (((a) & ~(m)) | ((b) & (m)))
            unsigned t8[8], t4[4];
#pragma unroll
            for (int j = 0; j < 8; ++j) t8[j] = ATT_BSEL(m0, __float_as_uint(gacc[2 * j]), __float_as_uint(gacc[2 * j + 1]));
#pragma unroll
            for (int j = 0; j < 4; ++j) t4[j] = ATT_BSEL(m1, t8[2 * j], t8[2 * j + 1]);
            const unsigned ta = ATT_BSEL(m2, t4[0], t4[1]), tb = ATT_BSEL(m2, t4[2], t4[3]);
            const float dg = __uint_as_float(ATT_BSEL(m3, ta, tb));
#undef ATT_BSEL
            const float rk = __builtin_amdgcn_rsqf(dg * (1.f / HD) + EPS);
            if (((rr >> 2) & 1) == hh) RK[rr] = rk; }
        __builtin_amdgcn_sched_barrier(0);
#pragma unroll
        for (int i = 0; i < 16; ++i) sacc[i] = 0.f;
#pragma unroll
        for (int ks = 0; ks < 8; ++ks) sacc = __builtin_amdgcn_mfma_f32_32x32x16_bf16(__builtin_bit_cast(bf16x8v, kraw[ks]), Qf[ks], sacc, 0, 0, 0);
#else
        {   float ss = 0.f;
#pragma unroll
            for (int ks = 0; ks < 8; ++ks) ss += sumsq8(kraw[ks]);
            ss = X32SUM(ss);
            const float rk = 1.0f / sqrtf(ss * (1.f / HD) + EPS);
            if (hh == 0) RK[rr] = rk; }
#pragma unroll
        for (int i = 0; i < 16; ++i) sacc[i] = 0.f;
#pragma unroll
        for (int ks = 0; ks < 8; ++ks) sacc = __builtin_amdgcn_mfma_f32_32x32x16_bf16(__builtin_bit_cast(bf16x8v, kraw[ks]), Qf[ks], sacc, 0, 0, 0);
#endif
#if !ATT_EARLY_PF
        if (kt < kt_hi) {
#pragma unroll
            for (int i = 0; i < 8; ++i) kst[i] = bload(rsK, lK, hsK + (unsigned)(ktokb + (32 * (kt + 1) + 4 * i) * d) * kpitch); }
#pragma unroll
        for (int i = 0; i < 8; ++i) *(LAS v4u*)(VB + wV[i & 3] + 1024 * i) = vst[i];
        if (kt < kt_hi) {
#pragma unroll
            for (int i = 0; i < 8; ++i) vst[i] = bload(rsV, lK, hsK + (unsigned)(ktokb + (32 * (kt + 1) + 4 * i) * d) * kpitch); }
#endif
        LDS_WAIT();
        float sv[16];
#pragma unroll
        for (int g = 0; g < 4; ++g) { const f32x4 r4 = *(const LAS f32x4*)(RK + 8 * g + 4 * hh);
            sv[4 * g + 0] = sacc[4 * g + 0] * r4.x; sv[4 * g + 1] = sacc[4 * g + 1] * r4.y; sv[4 * g + 2] = sacc[4 * g + 2] * r4.z; sv[4 * g + 3] = sacc[4 * g + 3] * r4.w; }
        if (MODE == 0) {
            if (kt == 0) {
#pragma unroll
                for (int i = 0; i < 16; ++i) { const int kk = (i & 3) + 8 * (i >> 2) + 4 * hh; sv[i] = (kk >= rr) ? sv[i] : -1e30f; } }
            if (kt == 4) {
#pragma unroll
                for (int i = 0; i < 16; ++i) { const int kk = (i & 3) + 8 * (i >> 2) + 4 * hh; sv[i] = (kk <= rr) ? sv[i] : -1e30f; } }
        }
        float mt = sv[0];
#pragma unroll
        for (int i = 1; i < 16; ++i) mt = fmaxf(mt, sv[i]);
        mt = X32MAX(mt);
        if (ATT_DEFER_MAX == 0 || __builtin_amdgcn_ballot_w64(mt > mrun + 8.f) != 0ull) {
            const float mn = fmaxf(mrun, mt), alpha = __builtin_amdgcn_exp2f(mrun - mn); mrun = mn; lrun *= alpha;
#pragma unroll
            for (int i = 0; i < 16; ++i) { O0[i] *= alpha; O1[i] *= alpha; O2[i] *= alpha; O3[i] *= alpha; } }
        float ps = 0.f;
#pragma unroll
        for (int i = 0; i < 16; ++i) { sv[i] = __builtin_amdgcn_exp2f(sv[i] - mrun); ps += sv[i]; }
#if !ATT_LSUM_LATE
        ps = X32SUM(ps);
#endif
        lrun += ps;
        v4u pw0, pw1;
        pw0.x = cvtpk(sv[0], sv[1]); pw0.y = cvtpk(sv[2], sv[3]); pw0.z = cvtpk(sv[4], sv[5]); pw0.w = cvtpk(sv[6], sv[7]);
        pw1.x = cvtpk(sv[8], sv[9]); pw1.y = cvtpk(sv[10], sv[11]); pw1.z = cvtpk(sv[12], sv[13]); pw1.w = cvtpk(sv[14], sv[15]);
        const bf16x8v P0 = __builtin_bit_cast(bf16x8v, pw0), P1 = __builtin_bit_cast(bf16x8v, pw1);
#define ATT_VFRAG(c, s) ({ const s16x4v lo_ = vtr(VB + vt_off(16u * (s) + 4u * hh + q_, 4u * (c) + 2u * blk + (p_ >> 1)) + 8u * (p_ & 1u)); \
                           const s16x4v hi_ = vtr(VB + vt_off(16u * (s) + 8u + 4u * hh + q_, 4u * (c) + 2u * blk + (p_ >> 1)) + 8u * (p_ & 1u)); \
                           (bf16x8v){lo_[0], lo_[1], lo_[2], lo_[3], hi_[0], hi_[1], hi_[2], hi_[3]}; })
        O0 = __builtin_amdgcn_mfma_f32_32x32x16_bf16(ATT_VFRAG(0, 0), P0, O0, 0, 0, 0); O0 = __builtin_amdgcn_mfma_f32_32x32x16_bf16(ATT_VFRAG(0, 1), P1, O0, 0, 0, 0);
        O1 = __builtin_amdgcn_mfma_f32_32x32x16_bf16(ATT_VFRAG(1, 0), P0, O1, 0, 0, 0); O1 = __builtin_amdgcn_mfma_f32_32x32x16_bf16(ATT_VFRAG(1, 1), P1, O1, 0, 0, 0);
        O2 = __builtin_amdgcn_mfma_f32_32x32x16_bf16(ATT_VFRAG(2, 0), P0, O2, 0, 0, 0); O2 = __builtin_amdgcn_mfma_f32_32x32x16_bf16(ATT_VFRAG(2, 1), P1, O2, 0, 0, 0);
        O3 = __builtin_amdgcn_mfma_f32_32x32x16_bf16(ATT_VFRAG(3, 0), P0, O3, 0, 0, 0); O3 = __builtin_amdgcn_mfma_f32_32x32x16_bf16(ATT_VFRAG(3, 1), P1, O3, 0, 0, 0);
#undef ATT_VFRAG
        LDS_WAIT();
    }
#if ATT_LSUM_LATE
    lrun = X32SUM(lrun);
#endif
    const float inv = 1.0f / lrun;
    const unsigned wO = (unsigned)(KTP * rr + 8 * hh);
#pragma unroll
    for (int g = 0; g < 4; ++g) {
        v2u w;
        w.x = cvtpk(O0[4 * g] * inv, O0[4 * g + 1] * inv); w.y = cvtpk(O0[4 * g + 2] * inv, O0[4 * g + 3] * inv); *(LAS v2u*)(KB + wO + 16 * (0 + g)) = w;
        w.x = cvtpk(O1[4 * g] * inv, O1[4 * g + 1] * inv); w.y = cvtpk(O1[4 * g + 2] * inv, O1[4 * g + 3] * inv); *(LAS v2u*)(KB + wO + 16 * (4 + g)) = w;
        w.x = cvtpk(O2[4 * g] * inv, O2[4 * g + 1] * inv); w.y = cvtpk(O2[4 * g + 2] * inv, O2[4 * g + 3] * inv); *(LAS v2u*)(KB + wO + 16 * (8 + g)) = w;
        w.x = cvtpk(O3[4 * g] * inv, O3[4 * g + 1] * inv); w.y = cvtpk(O3[4 * g + 2] * inv, O3[4 * g + 3] * inv); *(LAS v2u*)(KB + wO + 16 * (12 + g)) = w;
    }
    LDS_WAIT();
#pragma unroll
    for (int i = 0; i < 8; ++i) { const v4u o = *(const LAS v4u*)(KB + wK + 4 * KTP * i); bstore(rsO, lO, hsO + (unsigned)(qtok0 + 4 * i * d) * opitch, o); }
    LDS_WAIT();
    if (MODE == 0 && hh == 0) ((GAS float*)LSE)[(((size_t)pat * NB + b) * NH + h) * S + r * (S / d) + 32 * qt + rr] = mrun + __builtin_amdgcn_logf(lrun);
}

struct P0Item { int k0, n0, nd0; };
__device__ __forceinline__ P0Item p0_decode(int N, int item, bool inperm) {
    const int nblk = N / 64, kb = item / nblk, nb = item - kb * nblk; P0Item t; t.k0 = 64 * kb; t.n0 = 64 * nb; t.nd0 = t.n0;
    if (inperm && t.n0 >= 6144 && t.n0 < 8192) { const int isg = t.n0 >= 7168, ch = t.n0 - (isg ? 7168 : 6144); t.nd0 = 6144 + 256 * (ch >> 7) + 128 * isg + (ch & 127); }
    return t;
}
__device__ __forceinline__ void p0_load(const float* W, int N, const P0Item& t, int lane, const float* gk, f32x4 (&v)[16], float (&gv)[16]) {
    const int kk = lane >> 4, c = lane & 15;
#pragma unroll
    for (int i = 0; i < 16; ++i) v[i] = *(const GAS f32x4*)(W + (size_t)(t.k0 + 4 * i + kk) * N + t.n0 + 4 * c);
    if (gk) {
#pragma unroll
        for (int i = 0; i < 16; ++i) gv[i] = ((const GAS float*)gk)[t.k0 + 4 * i + kk]; }
}
__device__ __forceinline__ void p0_finish(int K, bf16* WT, LAS unsigned char* scr, const P0Item& t, int lane, bool hasg, f32x4 (&v)[16], const float (&gv)[16]) {
    const int kk = lane >> 4, c = lane & 15;
    if (hasg) {
#pragma unroll
        for (int i = 0; i < 16; ++i) v[i] = v[i] * gv[i]; }
#pragma unroll
    for (int i = 0; i < 16; ++i) { v2u o; o.x = cvtpk(v[i].x, v[i].y); o.y = cvtpk(v[i].z, v[i].w); *(LAS v2u*)(scr + (4 * i + kk) * 160 + 8 * c) = o; }
    LDS_WAIT();
    const int g = lane >> 4, q = (lane & 15) >> 2, p = lane & 3, i16 = lane & 15, odd = g & 1;
#pragma unroll
    for (int nb4 = 0; nb4 < 4; ++nb4)
#pragma unroll
        for (int hs = 0; hs < 2; ++hs) { const int kc = 4 * hs + g; const int b0 = 2 * kc + odd, b1 = 2 * kc + 1 - odd;
            const s16x4v r0 = vtr(scr + (4 * b0 + q) * 160 + 32 * nb4 + 8 * p), r1 = vtr(scr + (4 * b1 + q) * 160 + 32 * nb4 + 8 * p);
            const s16x4v lo = odd ? r1 : r0, hi = odd ? r0 : r1;
            const bf16x8v o = {lo[0], lo[1], lo[2], lo[3], hi[0], hi[1], hi[2], hi[3]};
            *(GAS bf16x8v*)(WT + (size_t)(t.nd0 + 16 * nb4 + i16) * K + t.k0 + 8 * kc) = o; }
    LDS_WAIT();
}
__device__ __forceinline__ void p0_transpose_tile(const float* W, int K, int N, bf16* WT, LAS unsigned char* scr, int item, int lane, bool inperm, const float* gk  ) {
    const P0Item t = p0_decode(N, item, inperm); f32x4 v[16]; float gv[16];
    p0_load(W, N, t, lane, gk, v, gv); p0_finish(K, WT, scr, t, lane, gk != nullptr, v, gv);
}
__device__ __forceinline__ void p0_transpose_pair(const float* W, int K, int N, bf16* WT, LAS unsigned char* scr, int itemA, int itemB, int lane, bool inperm, const float* gk) {
    const P0Item ta = p0_decode(N, itemA, inperm), tb = p0_decode(N, itemB, inperm); f32x4 va[16], vb[16]; float ga[16], gb[16];
    p0_load(W, N, ta, lane, gk, va, ga); p0_load(W, N, tb, lane, gk, vb, gb);
    VM_WAIT();
    p0_finish(K, WT, scr, ta, lane, gk != nullptr, va, ga); p0_finish(K, WT, scr, tb, lane, gk != nullptr, vb, gb);
}

__device__ __forceinline__ void conv_finish(float (&acc)[16], int t, const float* lng, const float* lnb, const float* gmix, bf16* mixed, int c0) {
    float s = 0.f;
#pragma unroll
    for (int k = 0; k < 16; ++k) s += acc[k];
    const float mean = wave_sum(s) * (1.f / CONV_W); float q2 = 0.f;
#pragma unroll
    for (int k = 0; k < 16; ++k) { acc[k] -= mean; q2 += acc[k] * acc[k]; }
    const float rs = 1.0f / sqrtf(wave_sum(q2) * (1.f / CONV_W) + EPS); float s2 = 0.f;
#pragma unroll
    for (int q = 0; q < 4; ++q) { const f32x4 lg = *(const GAS f32x4*)(lng + c0 + 4 * q), lb = *(const GAS f32x4*)(lnb + c0 + 4 * q);
        float y;
        y = acc[4 * q + 0] * rs * lg.x + lb.x; acc[4 * q + 0] = y * sigm(y); y = acc[4 * q + 1] * rs * lg.y + lb.y; acc[4 * q + 1] = y * sigm(y);
        y = acc[4 * q + 2] * rs * lg.z + lb.z; acc[4 * q + 2] = y * sigm(y); y = acc[4 * q + 3] * rs * lg.w + lb.w; acc[4 * q + 3] = y * sigm(y); }
#pragma unroll
    for (int k = 0; k < 16; ++k) s2 += acc[k] * acc[k];
    const float r = 1.0f / sqrtf(wave_sum(s2) * (1.f / CONV_W) + EPS);
    unsigned ow[8];
#pragma unroll
    for (int q = 0; q < 4; ++q) { const f32x4 gm = *(const GAS f32x4*)(gmix + 2048 + c0 + 4 * q);
        ow[2 * q] = pk2(acc[4 * q] * r * gm.x, acc[4 * q + 1] * r * gm.y); ow[2 * q + 1] = pk2(acc[4 * q + 2] * r * gm.z, acc[4 * q + 3] * r * gm.w); }
    GAS v4u* op = (GAS v4u*)(mixed + (size_t)t * D + 2048 + c0);
    op[0] = (v4u){ow[0], ow[1], ow[2], ow[3]}; op[1] = (v4u){ow[4], ow[5], ow[6], ow[7]};
}

__device__ __forceinline__ void conv_naive_item(int t, const bf16* CH, const float* dw, const float* cb, const float* lng, const float* lnb, const float* gmix, bf16* mixed, int lane) {
    const int b = t >> 12, ts = t & (S - 1), c0 = 16 * lane;
    float acc[16];
#pragma unroll
    for (int q = 0; q < 4; ++q) { const f32x4 v = *(const GAS f32x4*)(cb + c0 + 4 * q); acc[4 * q] = v.x; acc[4 * q + 1] = v.y; acc[4 * q + 2] = v.z; acc[4 * q + 3] = v.w; }
    const int j0 = ts >= CONV_K - 1 ? 0 : CONV_K - 1 - ts;
#pragma unroll 4
    for (int j = j0; j < CONV_K; ++j) {
        const size_t ro = (size_t)(b * S + ts - (CONV_K - 1) + j) * 1024 + c0;
        const v4u a0 = *(const GAS v4u*)(CH + ro), a1 = *(const GAS v4u*)(CH + ro + 8);
        const unsigned aw[8] = {a0.x, a0.y, a0.z, a0.w, a1.x, a1.y, a1.z, a1.w};
        const GAS f32x4* w4 = (const GAS f32x4*)(dw + (size_t)j * CONV_W + c0);
#pragma unroll
        for (int q = 0; q < 4; ++q) { const f32x4 w = w4[q];
            acc[4 * q + 0] += w.x * blo(aw[2 * q]); acc[4 * q + 1] += w.y * bhi(aw[2 * q]); acc[4 * q + 2] += w.z * blo(aw[2 * q + 1]); acc[4 * q + 3] += w.w * bhi(aw[2 * q + 1]); }
    }
    conv_finish(acc, t, lng, lnb, gmix, mixed, c0);
}

__device__ __forceinline__ void conv_item4(int t0, const bf16* CH, const float* dw, const float* cb, const float* lng, const float* lnb, const float* gmix, bf16* mixed, int lane) {
    const int b = t0 >> 12, ts0 = t0 & (S - 1), c0 = 16 * lane;
    float acc[4][16];
#pragma unroll
    for (int q = 0; q < 4; ++q) { const f32x4 v = *(const GAS f32x4*)(cb + c0 + 4 * q);
#pragma unroll
        for (int k = 0; k < 4; ++k) { acc[k][4 * q] = v.x; acc[k][4 * q + 1] = v.y; acc[k][4 * q + 2] = v.z; acc[k][4 * q + 3] = v.w; } }
#pragma unroll 1
    for (int j = 0; j < CONV_K; ++j) {
        const GAS f32x4* w4 = (const GAS f32x4*)(dw + (size_t)j * CONV_W + c0);
        const f32x4 wa = w4[0], wb = w4[1], wc = w4[2], wd = w4[3];
#pragma unroll
        for (int k = 0; k < 4; ++k) { const int tt = ts0 + k - (CONV_K - 1) + j;
            if (tt >= 0) {
                const size_t ro = (size_t)(b * S + tt) * 1024 + c0;
                const v4u a0 = *(const GAS v4u*)(CH + ro), a1 = *(const GAS v4u*)(CH + ro + 8);
                acc[k][0] += wa.x * blo(a0.x); acc[k][1] += wa.y * bhi(a0.x); acc[k][2] += wa.z * blo(a0.y); acc[k][3] += wa.w * bhi(a0.y);
                acc[k][4] += wb.x * blo(a0.z); acc[k][5] += wb.y * bhi(a0.z); acc[k][6] += wb.z * blo(a0.w); acc[k][7] += wb.w * bhi(a0.w);
                acc[k][8] += wc.x * blo(a1.x); acc[k][9] += wc.y * bhi(a1.x); acc[k][10] += wc.z * blo(a1.y); acc[k][11] += wc.w * bhi(a1.y);
                acc[k][12] += wd.x * blo(a1.z); acc[k][13] += wd.y * bhi(a1.z); acc[k][14] += wd.z * blo(a1.w); acc[k][15] += wd.w * bhi(a1.w); } }
    }
#pragma unroll
    for (int k = 0; k < 4; ++k) conv_finish(acc[k], t0 + k, lng, lnb, gmix, mixed, c0);
}

__device__ __forceinline__ void conv_stage_weights(const float* dw, LAS unsigned char* lds, int tid) {
    for (int e = tid; e < CONV_K * CONV_W / 4; e += NWAVES * 64) { const int j = e >> 8, c4 = e & 255;
        *(LAS f32x4*)(lds + j * 4096 + (c4 & 3) * 1024 + (c4 >> 2) * 16) = *(const GAS f32x4*)(dw + (size_t)j * CONV_W + 4 * c4); }
}
__device__ __forceinline__ void conv_item4w(int t0, const bf16* CH, const LAS unsigned char* wl, const float* cb, const float* lng, const float* lnb, const float* gmix, bf16* mixed, int lane) {
    const int b = t0 >> 12, ts0 = t0 & (S - 1), c0 = 16 * lane;
    float acc[4][16];
#pragma unroll
    for (int q = 0; q < 4; ++q) { const f32x4 v = *(const GAS f32x4*)(cb + c0 + 4 * q);
#pragma unroll
        for (int k = 0; k < 4; ++k) { acc[k][4 * q] = v.x; acc[k][4 * q + 1] = v.y; acc[k][4 * q + 2] = v.z; acc[k][4 * q + 3] = v.w; } }
    const int rho0 = ts0 >= CONV_K - 1 ? 0 : CONV_K - 1 - ts0;
#pragma unroll 2
    for (int rho = rho0; rho < CONV_K + 3; ++rho) {
        const size_t ro = (size_t)(b * S + ts0 - (CONV_K - 1) + rho) * 1024 + c0;
        const v4u a0 = *(const GAS v4u*)(CH + ro), a1 = *(const GAS v4u*)(CH + ro + 8);
        const float h0 = blo(a0.x), h1 = bhi(a0.x), h2 = blo(a0.y), h3 = bhi(a0.y), h4 = blo(a0.z), h5 = bhi(a0.z), h6 = blo(a0.w), h7 = bhi(a0.w);
        const float h8 = blo(a1.x), h9 = bhi(a1.x), h10 = blo(a1.y), h11 = bhi(a1.y), h12 = blo(a1.z), h13 = bhi(a1.z), h14 = blo(a1.w), h15 = bhi(a1.w);
#pragma unroll
        for (int k = 0; k < 4; ++k) { const int j = rho - k;
            if ((unsigned)j < (unsigned)CONV_K) {
                const LAS f32x4* w4 = (const LAS f32x4*)(wl + j * 4096 + lane * 16);
                const f32x4 wa = w4[0], wb = w4[64], wc = w4[128], wd = w4[192];
                acc[k][0] += wa.x * h0; acc[k][1] += wa.y * h1; acc[k][2] += wa.z * h2; acc[k][3] += wa.w * h3;
                acc[k][4] += wb.x * h4; acc[k][5] += wb.y * h5; acc[k][6] += wb.z * h6; acc[k][7] += wb.w * h7;
                acc[k][8] += wc.x * h8; acc[k][9] += wc.y * h9; acc[k][10] += wc.z * h10; acc[k][11] += wc.w * h11;
                acc[k][12] += wd.x * h12; acc[k][13] += wd.y * h13; acc[k][14] += wd.z * h14; acc[k][15] += wd.w * h15; } }
    }
#pragma unroll
    for (int k = 0; k < 4; ++k) conv_finish(acc[k], t0 + k, lng, lnb, gmix, mixed, c0);
}

constexpr int CONV_RD = 4;
__device__ __forceinline__ void conv_item4p(int t0, const bf16* CH, const LAS unsigned char* wl, const float* cb, const float* lng, const float* lnb, const float* gmix, bf16* mixed, int lane) {
    const int b = t0 >> 12, ts0 = t0 & (S - 1), c0 = 16 * lane;
    float acc[4][16];
#pragma unroll
    for (int q = 0; q < 4; ++q) { const f32x4 v = *(const GAS f32x4*)(cb + c0 + 4 * q);
#pragma unroll
        for (int k = 0; k < 4; ++k) { acc[k][4 * q] = v.x; acc[k][4 * q + 1] = v.y; acc[k][4 * q + 2] = v.z; acc[k][4 * q + 3] = v.w; } }
    const int rho0 = ts0 >= CONV_K - 1 ? 0 : CONV_K - 1 - ts0;
    const bf16* base = CH + (size_t)(b * S) * 1024 + c0;
    v4u ra[CONV_RD], rb[CONV_RD]; f32x4 wt[4][4];
#pragma unroll
    for (int a = 0; a < 4; ++a)
#pragma unroll
        for (int q = 0; q < 4; ++q) wt[a][q] = (f32x4){0.f, 0.f, 0.f, 0.f};
#define CONV_LD(rho_, slot_) do { int rr_ = (rho_); rr_ = rr_ > CONV_K + 2 ? CONV_K + 2 : rr_; int tk_ = ts0 - (CONV_K - 1) + rr_; tk_ = tk_ < 0 ? 0 : tk_; \
        const GAS v4u* p_ = (const GAS v4u*)(base + (size_t)tk_ * 1024); ra[slot_] = p_[0]; rb[slot_] = p_[1]; } while (0)
#pragma unroll
    for (int i = 0; i < CONV_RD; ++i) CONV_LD(i, i);
#pragma unroll 1
    for (int r8 = 0; r8 < CONV_K + 3; r8 += CONV_RD) {
#pragma unroll
        for (int i = 0; i < CONV_RD; ++i) { const int rho = r8 + i;
            v4u a0 = ra[i], a1 = rb[i];
            CONV_LD(rho + CONV_RD, i);
            const unsigned mk = rho >= rho0 ? ~0u : 0u;
            a0.x &= mk; a0.y &= mk; a0.z &= mk; a0.w &= mk; a1.x &= mk; a1.y &= mk; a1.z &= mk; a1.w &= mk;
            const float h0 = blo(a0.x), h1 = bhi(a0.x), h2 = blo(a0.y), h3 = bhi(a0.y), h4 = blo(a0.z), h5 = bhi(a0.z), h6 = blo(a0.w), h7 = bhi(a0.w);
            const float h8 = blo(a1.x), h9 = bhi(a1.x), h10 = blo(a1.y), h11 = bhi(a1.y), h12 = blo(a1.z), h13 = bhi(a1.z), h14 = blo(a1.w), h15 = bhi(a1.w);
            {   const int jn = rho < CONV_K ? rho : CONV_K - 1;
                const LAS f32x4* w4 = (const LAS f32x4*)(wl + jn * 4096 + lane * 16);
                wt[i & 3][0] = w4[0]; wt[i & 3][1] = w4[64]; wt[i & 3][2] = w4[128]; wt[i & 3][3] = w4[192]; }
#pragma unroll
            for (int k = 0; k < 4; ++k) { const int j = rho - k;
                if ((unsigned)j < (unsigned)CONV_K) {
                    const f32x4 wa = wt[(i - k) & 3][0], wb = wt[(i - k) & 3][1], wc = wt[(i - k) & 3][2], wd = wt[(i - k) & 3][3];
                    acc[k][0] += wa.x * h0; acc[k][1] += wa.y * h1; acc[k][2] += wa.z * h2; acc[k][3] += wa.w * h3;
                    acc[k][4] += wb.x * h4; acc[k][5] += wb.y * h5; acc[k][6] += wb.z * h6; acc[k][7] += wb.w * h7;
                    acc[k][8] += wc.x * h8; acc[k][9] += wc.y * h9; acc[k][10] += wc.z * h10; acc[k][11] += wc.w * h11;
                    acc[k][12] += wd.x * h12; acc[k][13] += wd.y * h13; acc[k][14] += wd.z * h14; acc[k][15] += wd.w * h15; } } }
    }
#undef CONV_LD
#pragma unroll
    for (int k = 0; k < 4; ++k) conv_finish(acc[k], t0 + k, lng, lnb, gmix, mixed, c0);
}

__device__ __forceinline__ void sincos_small(float x, float& sn, float& cs) {
    const float k = rintf(x * 0.636619772367581343f);
    float r = fmaf(-k, 1.5703125f, x); r = fmaf(-k, 4.837512969970703125e-4f, r); r = fmaf(-k, 7.54978995489188216e-8f, r);
    const int q = (int)k & 3; const float r2 = r * r;
    const float sp = r + r * r2 * (-1.6666654611e-1f + r2 * (8.3321608736e-3f + r2 * (-1.9515295891e-4f)));
    const float cp = 1.0f + r2 * (-0.5f + r2 * (4.166664568298827e-2f + r2 * (-1.388731625493765e-3f + r2 * 2.443315711809948e-5f)));
    const float s0 = (q & 1) ? cp : sp, c0 = (q & 1) ? sp : cp;
    sn = (q & 2) ? -s0 : s0; cs = ((q + 1) & 2) ? -c0 : c0;
}
__device__ __forceinline__ float gelu_tanh(float y) { const float a = 0.7978845608028654f * (y + 0.044715f * y * y * y); const float e = __expf(2.f * a); const float th = 1.f - 2.f / (e + 1.f); return 0.5f * y * (1.f + th); }
template <bool PASS2> __device__ __forceinline__ void ssm_scan_chunk(const bf16* SU, bf16* Z, int b, int g, int wave, int lane, const float (&bbr)[16], const float (&bbi)[16], float lr, float li_, float& xr, float& xi,
                                                                    const float* dsk, LAS unsigned char* wl, const LAS float* Cs) {
    LAS v4u* Us4 = (LAS v4u*)wl;
    LAS float* Xs = (LAS float*)(wl + 512);
    const int tokl = lane >> 2, hq = lane & 3;
    const bf16* ubase = SU + (size_t)(b * S + 512 * wave + (lane >> 1)) * 1024 + 16 * g + 8 * (lane & 1);
    v4u unext = (v4u){0u, 0u, 0u, 0u};
    if (lane < 32) unext = *(const GAS v4u*)ubase;
    for (int kb = 0; kb < 32; ++kb) {
        const int tok0 = b * S + 512 * wave + 16 * kb;
        if (lane < 32) Us4[lane] = unext;
        if (lane < 32 && kb < 31) unext = *(const GAS v4u*)(ubase + (size_t)(kb + 1) * 16 * 1024);
        LDS_WAIT();
#pragma unroll 4
        for (int tk = 0; tk < 16; ++tk) {
            const v4u ua = Us4[2 * tk], ub = Us4[2 * tk + 1];
            const float u0 = blo(ua.x), u1 = bhi(ua.x), u2 = blo(ua.y), u3 = bhi(ua.y), u4 = blo(ua.z), u5 = bhi(ua.z), u6 = blo(ua.w), u7 = bhi(ua.w);
            const float u8 = blo(ub.x), u9 = bhi(ub.x), u10 = blo(ub.y), u11 = bhi(ub.y), u12 = blo(ub.z), u13 = bhi(ub.z), u14 = blo(ub.w), u15 = bhi(ub.w);
            const float bur = ((bbr[0] * u0 + bbr[1] * u1) + (bbr[2] * u2 + bbr[3] * u3)) + ((bbr[4] * u4 + bbr[5] * u5) + (bbr[6] * u6 + bbr[7] * u7)) +
                              ((bbr[8] * u8 + bbr[9] * u9) + (bbr[10] * u10 + bbr[11] * u11)) + ((bbr[12] * u12 + bbr[13] * u13) + (bbr[14] * u14 + bbr[15] * u15));
            const float bui = ((bbi[0] * u0 + bbi[1] * u1) + (bbi[2] * u2 + bbi[3] * u3)) + ((bbi[4] * u4 + bbi[5] * u5) + (bbi[6] * u6 + bbi[7] * u7)) +
                              ((bbi[8] * u8 + bbi[9] * u9) + (bbi[10] * u10 + bbi[11] * u11)) + ((bbi[12] * u12 + bbi[13] * u13) + (bbi[14] * u14 + bbi[15] * u15));
            const float nxr = lr * xr - li_ * xi + bur, nxi = lr * xi + li_ * xr + bui; xr = nxr; xi = nxi;
            if (PASS2) { Xs[lane * 17 + tk] = xr; Xs[1088 + lane * 17 + tk] = xi; }
        }
        if (PASS2) {
            LDS_WAIT();
            float y0 = 0.f, y1 = 0.f, y2 = 0.f, y3 = 0.f;
#pragma unroll 8
            for (int p = 0; p < 64; ++p) { const float xre = Xs[p * 17 + tokl], xim = Xs[1088 + p * 17 + tokl];
                const f32x4 cre = *(const LAS f32x4*)(Cs + p * 32 + 4 * hq), cim = *(const LAS f32x4*)(Cs + p * 32 + 16 + 4 * hq);
                y0 += cre.x * xre - cim.x * xim; y1 += cre.y * xre - cim.y * xim; y2 += cre.z * xre - cim.z * xim; y3 += cre.w * xre - cim.w * xim; }
            const v2u uu = *(const LAS v2u*)(wl + tokl * 32 + hq * 8);
            const f32x4 dk = *(const GAS f32x4*)(dsk + 16 * g + 4 * hq);
            y0 += dk.x * blo(uu.x); y1 += dk.y * bhi(uu.x); y2 += dk.z * blo(uu.y); y3 += dk.w * bhi(uu.y);
            v2u o; o.x = pk2(gelu_tanh(y0), gelu_tanh(y1)); o.y = pk2(gelu_tanh(y2), gelu_tanh(y3));
            *(GAS v2u*)(Z + (size_t)(tok0 + tokl) * 1024 + 16 * g + 4 * hq) = o;
        }
        LDS_WAIT();
    }
}
__device__ __forceinline__ void ssm_unit(int unit, int l, const float* a_re, const float* a_im, const float* b_re, const float* b_im, const float* c_re, const float* c_im, const float* dsk, const float* log_step,
                                         const bf16* SU, bf16* Z, LAS unsigned char* lds, int tid, int wave, int lane) {
    const int b = unit >> 6, g = unit & 63, lg = l * SSM_G + g;
    LAS float* Cs = (LAS float*)lds;
    LAS float* Es = (LAS float*)(lds + 8192);
    LAS unsigned char* wl = lds + 16384 + wave * 12288;
    for (int e = tid; e < 1024; e += NWAVES * 64) { const int p = e >> 4, h = e & 15; Cs[p * 32 + h] = ((const GAS float*)c_re)[((size_t)lg * 16 + h) * 64 + p]; Cs[p * 32 + 16 + h] = ((const GAS float*)c_im)[((size_t)lg * 16 + h) * 64 + p]; }
    const float are = ((const GAS float*)a_re)[lg * 64 + lane], aim = ((const GAS float*)a_im)[lg * 64 + lane], step = expf(((const GAS float*)log_step)[lg]);
    float sn, cs; sincos_small(aim * step, sn, cs);
    const float er = expf(are * step), lr = er * cs, li_ = er * sn;
    const float den = 1.0f / (are * are + aim * aim), nr = lr - 1.0f, cr = (nr * are + li_ * aim) * den, ci = (li_ * are - nr * aim) * den;
    float bbr[16], bbi[16];
#pragma unroll
    for (int q = 0; q < 4; ++q) { const f32x4 br = *(const GAS f32x4*)(b_re + ((size_t)lg * 64 + lane) * 16 + 4 * q), bi = *(const GAS f32x4*)(b_im + ((size_t)lg * 64 + lane) * 16 + 4 * q);
        bbr[4 * q + 0] = cr * br.x - ci * bi.x; bbi[4 * q + 0] = cr * bi.x + ci * br.x; bbr[4 * q + 1] = cr * br.y - ci * bi.y; bbi[4 * q + 1] = cr * bi.y + ci * br.y;
        bbr[4 * q + 2] = cr * br.z - ci * bi.z; bbi[4 * q + 2] = cr * bi.z + ci * br.z; bbr[4 * q + 3] = cr * br.w - ci * bi.w; bbi[4 * q + 3] = cr * bi.w + ci * br.w; }
    float Lr = lr, Li = li_;
#pragma unroll
    for (int q = 0; q < 9; ++q) { const float t0 = Lr * Lr - Li * Li, t1 = 2.f * Lr * Li; Lr = t0; Li = t1; }
    float xr = 0.f, xi = 0.f;
    ssm_scan_chunk<false>(SU, Z, b, g, wave, lane, bbr, bbi, lr, li_, xr, xi, dsk, wl, Cs);
    Es[(wave * 64 + lane) * 2] = xr; Es[(wave * 64 + lane) * 2 + 1] = xi;
    LDS_WAIT(); __syncthreads();
    xr = 0.f; xi = 0.f;
    for (int c = 0; c < wave; ++c) { const float er_ = Es[(c * 64 + lane) * 2], ei_ = Es[(c * 64 + lane) * 2 + 1]; const float t0 = Lr * xr - Li * xi + er_, t1 = Lr * xi + Li * xr + ei_; xr = t0; xi = t1; }
    ssm_scan_chunk<true>(SU, Z, b, g, wave, lane, bbr, bbi, lr, li_, xr, xi, dsk, wl, Cs);
    LDS_WAIT(); __syncthreads();
}

__device__ __forceinline__ f32x16 zero16() { f32x16 z;
#pragma unroll
    for (int i = 0; i < 16; ++i) z[i] = 0.f; return z; }
template <bool PASS2> __device__ __forceinline__ void ssm_mfma_pass(const bf16* SU, bf16* Z, int b, int g, int wave, int lane, bf16x8v Bre0, bf16x8v Bre1, bf16x8v Bim0, bf16x8v Bim1,
                                                                   const bf16x8v (&Cf)[8], bf16x8v Df, float lr0, float li0, float lr1, float li1, float& x0r, float& x0i, float& x1r, float& x1i, LAS unsigned char* img) {
    const int c = lane & 31, hh = lane >> 5;
    const int strm = (c >> 2) & 1, idx = 4 * (c >> 3) + (c & 3);
    const bf16* up = SU + (size_t)(b * S + (2 * wave + strm) * 256 + idx) * 1024 + 16 * g + 8 * hh;
    const int q = (lane & 15) >> 2, p = lane & 3, blk = (lane >> 4) & 1;
    v4u unext = *(const GAS v4u*)up;
    for (int tile = 0; tile < 16; ++tile) {
        const bf16x8v Uf = __builtin_bit_cast(bf16x8v, unext);
        if (tile < 15) unext = *(const GAS v4u*)(up + (size_t)(tile + 1) * 16 * 1024);
        f32x16 are0 = __builtin_amdgcn_mfma_f32_32x32x16_bf16(Uf, Bre0, zero16(), 0, 0, 0), aim0 = __builtin_amdgcn_mfma_f32_32x32x16_bf16(Uf, Bim0, zero16(), 0, 0, 0);
        f32x16 are1 = __builtin_amdgcn_mfma_f32_32x32x16_bf16(Uf, Bre1, zero16(), 0, 0, 0), aim1 = __builtin_amdgcn_mfma_f32_32x32x16_bf16(Uf, Bim1, zero16(), 0, 0, 0);
#pragma unroll
        for (int r = 0; r < 16; ++r) {
            const float n0r = lr0 * x0r - li0 * x0i + are0[r], n0i = lr0 * x0i + li0 * x0r + aim0[r]; x0r = n0r; x0i = n0i;
            const float n1r = lr1 * x1r - li1 * x1i + are1[r], n1i = lr1 * x1i + li1 * x1r + aim1[r]; x1r = n1r; x1i = n1i;
            if (PASS2) { are0[r] = x0r; aim0[r] = x0i; are1[r] = x1r; aim1[r] = x1i; }
        }
        if (PASS2) {
#pragma unroll
            for (int gq = 0; gq < 4; ++gq) { v2u w; const int o = c * 64 + 8 * (2 * gq + hh);
                w.x = cvtpk(are0[4 * gq], are0[4 * gq + 1]); w.y = cvtpk(are0[4 * gq + 2], are0[4 * gq + 3]); *(LAS v2u*)(img + 0 * 2048 + o) = w;
                w.x = cvtpk(are1[4 * gq], are1[4 * gq + 1]); w.y = cvtpk(are1[4 * gq + 2], are1[4 * gq + 3]); *(LAS v2u*)(img + 1 * 2048 + o) = w;
                w.x = cvtpk(aim0[4 * gq], aim0[4 * gq + 1]); w.y = cvtpk(aim0[4 * gq + 2], aim0[4 * gq + 3]); *(LAS v2u*)(img + 2 * 2048 + o) = w;
                w.x = cvtpk(aim1[4 * gq], aim1[4 * gq + 1]); w.y = cvtpk(aim1[4 * gq + 2], aim1[4 * gq + 3]); *(LAS v2u*)(img + 3 * 2048 + o) = w; }
            LDS_WAIT();
            f32x16 y = __builtin_amdgcn_mfma_f32_32x32x16_bf16(Uf, Df, zero16(), 0, 0, 0);
#pragma unroll
            for (int T = 0; T < 4; ++T)
#pragma unroll
                for (int s = 0; s < 2; ++s) { const LAS unsigned char* a = img + T * 2048 + (16 * s + 8 * hh + q) * 64 + 8 * (4 * blk + p);
                    const s16x4v lo = vtr(a), hi = vtr(a + 4 * 64);
                    const bf16x8v xa = {lo[0], lo[1], lo[2], lo[3], hi[0], hi[1], hi[2], hi[3]};
                    y = __builtin_amdgcn_mfma_f32_32x32x16_bf16(xa, Cf[2 * T + s], y, 0, 0, 0); }
            {
                LDS_WAIT();
                LAS bf16* zt = (LAS bf16*)img;
                if (c < 16) {
#pragma unroll
                    for (int r = 0; r < 16; ++r) zt[(hh * 16 + r) * 16 + c] = (bf16)f2bf(gelu_tanh(y[r])); }
                LDS_WAIT();
                const int ti = lane >> 1, hf = lane & 1;
                const v4u zv = *(const LAS v4u*)(img + ti * 32 + hf * 16);
                *(GAS v4u*)(Z + (size_t)(b * S + (2 * wave + (ti >> 4)) * 256 + 16 * tile + (ti & 15)) * 1024 + 16 * g + 8 * hf) = zv;
            }
            LDS_WAIT();
        }
    }
}
__device__ __forceinline__ bf16x8v pack8(const float (&v)[8]) { v4u w; w.x = cvtpk(v[0], v[1]); w.y = cvtpk(v[2], v[3]); w.z = cvtpk(v[4], v[5]); w.w = cvtpk(v[6], v[7]); return __builtin_bit_cast(bf16x8v, w); }
__device__ __forceinline__ void ssm_disc(const float* a_re, const float* a_im, int lg, int pst, float step, float& lr, float& li_, float& cr, float& ci) {
    const float are = ((const GAS float*)a_re)[lg * 64 + pst], aim = ((const GAS float*)a_im)[lg * 64 + pst]; float sn, cs; sincos_small(aim * step, sn, cs);
    const float er = expf(are * step); lr = er * cs; li_ = er * sn;
    const float den = 1.0f / (are * are + aim * aim), nr = lr - 1.0f; cr = (nr * are + li_ * aim) * den; ci = (li_ * are - nr * aim) * den;
}
__device__ __forceinline__ void ssm_unit_mfma(int unit, int l, const float* a_re, const float* a_im, const float* b_re, const float* b_im, const float* c_re, const float* c_im, const float* dsk, const float* log_step,
                                              const bf16* SU, bf16* Z, LAS unsigned char* lds, int wave, int lane) {
    const int b = unit >> 6, g = unit & 63, lg = l * SSM_G + g;
    const int c = lane & 31, hh = lane >> 5;
    LAS float* Es = (LAS float*)lds;
    LAS unsigned char* img = lds + 8192 + wave * 8192;
    const float step = expf(((const GAS float*)log_step)[lg]);
    float lr0, li0, cr0, ci0, lr1, li1, cr1, ci1;
    ssm_disc(a_re, a_im, lg, c, step, lr0, li0, cr0, ci0); ssm_disc(a_re, a_im, lg, c + 32, step, lr1, li1, cr1, ci1);
    bf16x8v Bre0, Bre1, Bim0, Bim1;
    {   float vr[8], vi[8];
        const GAS f32x4* br = (const GAS f32x4*)(b_re + ((size_t)lg * 64 + c) * 16 + 8 * hh); const GAS f32x4* bi = (const GAS f32x4*)(b_im + ((size_t)lg * 64 + c) * 16 + 8 * hh);
        f32x4 r0 = br[0], r1 = br[1], i0 = bi[0], i1 = bi[1];
        float rr_[8] = {r0.x, r0.y, r0.z, r0.w, r1.x, r1.y, r1.z, r1.w}, ii_[8] = {i0.x, i0.y, i0.z, i0.w, i1.x, i1.y, i1.z, i1.w};
#pragma unroll
        for (int j = 0; j < 8; ++j) { vr[j] = cr0 * rr_[j] - ci0 * ii_[j]; vi[j] = cr0 * ii_[j] + ci0 * rr_[j]; }
        Bre0 = pack8(vr); Bim0 = pack8(vi);
        br += 32 * 4; bi += 32 * 4;
        r0 = br[0]; r1 = br[1]; i0 = bi[0]; i1 = bi[1];
        float rr2[8] = {r0.x, r0.y, r0.z, r0.w, r1.x, r1.y, r1.z, r1.w}, ii2[8] = {i0.x, i0.y, i0.z, i0.w, i1.x, i1.y, i1.z, i1.w};
#pragma unroll
        for (int j = 0; j < 8; ++j) { vr[j] = cr1 * rr2[j] - ci1 * ii2[j]; vi[j] = cr1 * ii2[j] + ci1 * rr2[j]; }
        Bre1 = pack8(vr); Bim1 = pack8(vi);
    }
    bf16x8v Cf[8], Df;
    {   const int hc = c & 15; const float msk = c < 16 ? 1.f : 0.f;
#pragma unroll
        for (int T = 0; T < 4; ++T)
#pragma unroll
            for (int s = 0; s < 2; ++s) { const float* src = (T < 2 ? c_re : c_im) + ((size_t)lg * 16 + hc) * 64 + 32 * (T & 1) + 16 * s + 8 * hh;
                const f32x4 a = *(const GAS f32x4*)src, bq = *(const GAS f32x4*)(src + 4); const float sg = (T < 2 ? msk : -msk);
                float v[8] = {a.x * sg, a.y * sg, a.z * sg, a.w * sg, bq.x * sg, bq.y * sg, bq.z * sg, bq.w * sg}; Cf[2 * T + s] = pack8(v); }
        const float dv = ((const GAS float*)dsk)[16 * g + hc] * msk; float v[8];
#pragma unroll
        for (int j = 0; j < 8; ++j) v[j] = (8 * hh + j == c) ? dv : 0.f;
        Df = pack8(v);
    }
    float L0r = lr0, L0i = li0, L1r = lr1, L1i = li1;
#pragma unroll
    for (int k = 0; k < 8; ++k) { float t0 = L0r * L0r - L0i * L0i, t1 = 2.f * L0r * L0i; L0r = t0; L0i = t1; t0 = L1r * L1r - L1i * L1i; t1 = 2.f * L1r * L1i; L1r = t0; L1i = t1; }
    float x0r = 0.f, x0i = 0.f, x1r = 0.f, x1i = 0.f;
    ssm_mfma_pass<false>(SU, Z, b, g, wave, lane, Bre0, Bre1, Bim0, Bim1, Cf, Df, lr0, li0, lr1, li1, x0r, x0i, x1r, x1i, img);
    { const int ch = 2 * wave + hh; Es[(ch * 64 + c) * 2] = x0r; Es[(ch * 64 + c) * 2 + 1] = x0i; Es[(ch * 64 + c + 32) * 2] = x1r; Es[(ch * 64 + c + 32) * 2 + 1] = x1i; }
    LDS_WAIT(); __syncthreads();
    x0r = 0.f; x0i = 0.f; x1r = 0.f; x1i = 0.f;
    { const int ch = 2 * wave + hh;
      for (int cc = 0; cc < ch; ++cc) { const float e0r = Es[(cc * 64 + c) * 2], e0i = Es[(cc * 64 + c) * 2 + 1], e1r = Es[(cc * 64 + c + 32) * 2], e1i = Es[(cc * 64 + c + 32) * 2 + 1];
          float t0 = L0r * x0r - L0i * x0i + e0r, t1 = L0r * x0i + L0i * x0r + e0i; x0r = t0; x0i = t1; t0 = L1r * x1r - L1i * x1i + e1r; t1 = L1r * x1i + L1i * x1r + e1i; x1r = t0; x1i = t1; } }
    ssm_mfma_pass<true>(SU, Z, b, g, wave, lane, Bre0, Bre1, Bim0, Bim1, Cf, Df, lr0, li0, lr1, li1, x0r, x0i, x1r, x1i, img);
    LDS_WAIT(); __syncthreads();
}

__device__ __forceinline__ void ssm_unit_hybrid(int unit, int l, const float* a_re, const float* a_im, const float* b_re, const float* b_im, const float* c_re, const float* c_im, const float* dsk, const float* log_step,
                                                const bf16* SU, bf16* Z, LAS unsigned char* lds, int tid, int wave, int lane) {
    const int b = unit >> 6, g = unit & 63, lg = l * SSM_G + g;
    LAS float* Cs = (LAS float*)lds;
    LAS float* Es = (LAS float*)(lds + 8192);
    LAS unsigned char* wl = lds + 16384 + wave * 12288;
    for (int e = tid; e < 1024; e += NWAVES * 64) { const int p = e >> 4, h = e & 15; Cs[p * 32 + h] = ((const GAS float*)c_re)[((size_t)lg * 16 + h) * 64 + p]; Cs[p * 32 + 16 + h] = ((const GAS float*)c_im)[((size_t)lg * 16 + h) * 64 + p]; }
    const float step = expf(((const GAS float*)log_step)[lg]);
    {
        const int c = lane & 31, hh = lane >> 5;
        float lr0, li0, cr0, ci0, lr1, li1, cr1, ci1;
        ssm_disc(a_re, a_im, lg, c, step, lr0, li0, cr0, ci0); ssm_disc(a_re, a_im, lg, c + 32, step, lr1, li1, cr1, ci1);
        bf16x8v Bre0, Bre1, Bim0, Bim1;
        {   float vr[8], vi[8];
            const GAS f32x4* br = (const GAS f32x4*)(b_re + ((size_t)lg * 64 + c) * 16 + 8 * hh); const GAS f32x4* bi = (const GAS f32x4*)(b_im + ((size_t)lg * 64 + c) * 16 + 8 * hh);
            f32x4 r0 = br[0], r1 = br[1], i0 = bi[0], i1 = bi[1];
            float rr_[8] = {r0.x, r0.y, r0.z, r0.w, r1.x, r1.y, r1.z, r1.w}, ii_[8] = {i0.x, i0.y, i0.z, i0.w, i1.x, i1.y, i1.z, i1.w};
#pragma unroll
            for (int j = 0; j < 8; ++j) { vr[j] = cr0 * rr_[j] - ci0 * ii_[j]; vi[j] = cr0 * ii_[j] + ci0 * rr_[j]; }
            Bre0 = pack8(vr); Bim0 = pack8(vi);
            br += 32 * 4; bi += 32 * 4;
            r0 = br[0]; r1 = br[1]; i0 = bi[0]; i1 = bi[1];
            float rr2[8] = {r0.x, r0.y, r0.z, r0.w, r1.x, r1.y, r1.z, r1.w}, ii2[8] = {i0.x, i0.y, i0.z, i0.w, i1.x, i1.y, i1.z, i1.w};
#pragma unroll
            for (int j = 0; j < 8; ++j) { vr[j] = cr1 * rr2[j] - ci1 * ii2[j]; vi[j] = cr1 * ii2[j] + ci1 * rr2[j]; }
            Bre1 = pack8(vr); Bim1 = pack8(vi);
        }
        bf16x8v Cdummy[8];
#pragma unroll
        for (int q = 0; q < 8; ++q) Cdummy[q] = Bre0;
        float x0r = 0.f, x0i = 0.f, x1r = 0.f, x1i = 0.f;
        ssm_mfma_pass<false>(SU, Z, b, g, wave, lane, Bre0, Bre1, Bim0, Bim1, Cdummy, Bre0, lr0, li0, lr1, li1, x0r, x0i, x1r, x1i, wl);
        const int ch = 2 * wave + hh; Es[(ch * 64 + c) * 2] = x0r; Es[(ch * 64 + c) * 2 + 1] = x0i; Es[(ch * 64 + c + 32) * 2] = x1r; Es[(ch * 64 + c + 32) * 2 + 1] = x1i;
    }
    float lr, li_, cr, ci; ssm_disc(a_re, a_im, lg, lane, step, lr, li_, cr, ci);
    float bbr[16], bbi[16];
#pragma unroll
    for (int q = 0; q < 4; ++q) { const f32x4 br = *(const GAS f32x4*)(b_re + ((size_t)lg * 64 + lane) * 16 + 4 * q), bi = *(const GAS f32x4*)(b_im + ((size_t)lg * 64 + lane) * 16 + 4 * q);
        bbr[4 * q + 0] = cr * br.x - ci * bi.x; bbi[4 * q + 0] = cr * bi.x + ci * br.x; bbr[4 * q + 1] = cr * br.y - ci * bi.y; bbi[4 * q + 1] = cr * bi.y + ci * br.y;
        bbr[4 * q + 2] = cr * br.z - ci * bi.z; bbi[4 * q + 2] = cr * bi.z + ci * br.z; bbr[4 * q + 3] = cr * br.w - ci * bi.w; bbi[4 * q + 3] = cr * bi.w + ci * br.w; }
    float Lr = lr, Li = li_;
#pragma unroll
    for (int q = 0; q < 8; ++q) { const float t0 = Lr * Lr - Li * Li, t1 = 2.f * Lr * Li; Lr = t0; Li = t1; }
    LDS_WAIT(); __syncthreads();
    float xr = 0.f, xi = 0.f;
    for (int cc = 0; cc < 2 * wave; ++cc) { const float er_ = Es[(cc * 64 + lane) * 2], ei_ = Es[(cc * 64 + lane) * 2 + 1]; const float t0 = Lr * xr - Li * xi + er_, t1 = Lr * xi + Li * xr + ei_; xr = t0; xi = t1; }
    ssm_scan_chunk<true>(SU, Z, b, g, wave, lane, bbr, bbi, lr, li_, xr, xi, dsk, wl, Cs);
    LDS_WAIT(); __syncthreads();
}

__device__ __forceinline__ void post_item(int t, const bf16* PART, const float* LSE, const bf16* SG, const float* gmix, bf16* mixed, int lane) {
    {
        const int hd = lane >> 2;
        const int b_ = t >> 12, ts_ = t & (S - 1);
        const GAS float* LSEg = (const GAS float*)LSE;
        const float L0 = LSEg[(((size_t)0 * NB + b_) * NH + hd) * S + ts_], L1 = LSEg[(((size_t)1 * NB + b_) * NH + hd) * S + (ts_ & 3) * (S / 4) + (ts_ >> 2)], L2 = LSEg[(((size_t)2 * NB + b_) * NH + hd) * S + (ts_ & 15) * (S / 16) + (ts_ >> 4)];
        const float mx = fmaxf(L0, fmaxf(L1, L2)); float w0 = __builtin_amdgcn_exp2f(L0 - mx), w1 = __builtin_amdgcn_exp2f(L1 - mx), w2 = __builtin_amdgcn_exp2f(L2 - mx);
        const float wi = 1.0f / (w0 + w1 + w2); w0 *= wi; w1 *= wi; w2 *= wi;
        const GAS v4u* p0 = (const GAS v4u*)(PART + (size_t)t * ATTN_W + 32 * lane); const GAS v4u* p1 = (const GAS v4u*)(PART + (size_t)M * ATTN_W + (size_t)t * ATTN_W + 32 * lane);
        const GAS v4u* p2 = (const GAS v4u*)(PART + (size_t)2 * M * ATTN_W + (size_t)t * ATTN_W + 32 * lane);
        float mv[32]; float s = 0.f;
#pragma unroll
        for (int q = 0; q < 4; ++q) { const v4u a = p0[q], b = p1[q], c = p2[q];
            mv[8 * q + 0] = w0 * blo(a.x) + w1 * blo(b.x) + w2 * blo(c.x); mv[8 * q + 1] = w0 * bhi(a.x) + w1 * bhi(b.x) + w2 * bhi(c.x);
            mv[8 * q + 2] = w0 * blo(a.y) + w1 * blo(b.y) + w2 * blo(c.y); mv[8 * q + 3] = w0 * bhi(a.y) + w1 * bhi(b.y) + w2 * bhi(c.y);
            mv[8 * q + 4] = w0 * blo(a.z) + w1 * blo(b.z) + w2 * blo(c.z); mv[8 * q + 5] = w0 * bhi(a.z) + w1 * bhi(b.z) + w2 * bhi(c.z);
            mv[8 * q + 6] = w0 * blo(a.w) + w1 * blo(b.w) + w2 * blo(c.w); mv[8 * q + 7] = w0 * bhi(a.w) + w1 * bhi(b.w) + w2 * bhi(c.w); }
#pragma unroll
        for (int k = 0; k < 32; ++k) s += mv[k] * mv[k];
        const float r = 1.0f / sqrtf(wave_sum(s) * (1.f / ATTN_W) + EPS);
        GAS v4u* op = (GAS v4u*)(mixed + (size_t)t * D + 32 * lane);
#pragma unroll
        for (int q = 0; q < 4; ++q) { const f32x4 g0 = *(const GAS f32x4*)(gmix + 32 * lane + 8 * q), g1 = *(const GAS f32x4*)(gmix + 32 * lane + 8 * q + 4);
            v4u o; o.x = pk2(mv[8 * q] * r * g0.x, mv[8 * q + 1] * r * g0.y); o.y = pk2(mv[8 * q + 2] * r * g0.z, mv[8 * q + 3] * r * g0.w);
            o.z = pk2(mv[8 * q + 4] * r * g1.x, mv[8 * q + 5] * r * g1.y); o.w = pk2(mv[8 * q + 6] * r * g1.z, mv[8 * q + 7] * r * g1.w); op[q] = o; }
    }
    {   const GAS v4u* sp = (const GAS v4u*)(SG + (size_t)t * SSM_W + 16 * lane); v4u a[2]; float s = 0.f;
#pragma unroll
        for (int q = 0; q < 2; ++q) { a[q] = sp[q]; const float e0 = blo(a[q].x), e1 = bhi(a[q].x), e2 = blo(a[q].y), e3 = bhi(a[q].y), e4 = blo(a[q].z), e5 = bhi(a[q].z), e6 = blo(a[q].w), e7 = bhi(a[q].w);
            s += (e0 * e0 + e1 * e1) + (e2 * e2 + e3 * e3) + (e4 * e4 + e5 * e5) + (e6 * e6 + e7 * e7); }
        const float r = 1.0f / sqrtf(wave_sum(s) * (1.f / SSM_W) + EPS);
        GAS v4u* op = (GAS v4u*)(mixed + (size_t)t * D + 3072 + 16 * lane);
#pragma unroll
        for (int q = 0; q < 2; ++q) { const f32x4 g0 = *(const GAS f32x4*)(gmix + 3072 + 16 * lane + 8 * q), g1 = *(const GAS f32x4*)(gmix + 3072 + 16 * lane + 8 * q + 4);
            v4u o; o.x = pk2(blo(a[q].x) * r * g0.x, bhi(a[q].x) * r * g0.y); o.y = pk2(blo(a[q].y) * r * g0.z, bhi(a[q].y) * r * g0.w);
            o.z = pk2(blo(a[q].z) * r * g1.x, bhi(a[q].z) * r * g1.y); o.w = pk2(blo(a[q].w) * r * g1.z, bhi(a[q].w) * r * g1.w); op[q] = o; }
    }
}

__device__ __forceinline__ void post_item2(int ta, int tb, const bf16* PART, const float* LSE, const bf16* SG, const float* gmix, bf16* mixed, int lane) {
    const int hd = lane >> 2; const GAS float* LSEg = (const GAS float*)LSE;
    float L[2][3]; v4u pa[2][3][4]; v4u sa[2][2];
#pragma unroll
    for (int u = 0; u < 2; ++u) { const int t = u ? tb : ta; const int b_ = t >> 12, ts_ = t & (S - 1);
        L[u][0] = LSEg[(((size_t)0 * NB + b_) * NH + hd) * S + ts_]; L[u][1] = LSEg[(((size_t)1 * NB + b_) * NH + hd) * S + (ts_ & 3) * (S / 4) + (ts_ >> 2)];
        L[u][2] = LSEg[(((size_t)2 * NB + b_) * NH + hd) * S + (ts_ & 15) * (S / 16) + (ts_ >> 4)];
#pragma unroll
        for (int pp = 0; pp < 3; ++pp) { const GAS v4u* p = (const GAS v4u*)(PART + (size_t)pp * M * ATTN_W + (size_t)t * ATTN_W + 32 * lane);
#pragma unroll
            for (int q = 0; q < 4; ++q) pa[u][pp][q] = p[q]; }
        const GAS v4u* sp = (const GAS v4u*)(SG + (size_t)t * SSM_W + 16 * lane); sa[u][0] = sp[0]; sa[u][1] = sp[1]; }
    VM_WAIT();
#pragma unroll
    for (int u = 0; u < 2; ++u) { const int t = u ? tb : ta;
        {   const float L0 = L[u][0], L1 = L[u][1], L2 = L[u][2];
            const float mx = fmaxf(L0, fmaxf(L1, L2)); float w0 = __builtin_amdgcn_exp2f(L0 - mx), w1 = __builtin_amdgcn_exp2f(L1 - mx), w2 = __builtin_amdgcn_exp2f(L2 - mx);
            const float wi = 1.0f / (w0 + w1 + w2); w0 *= wi; w1 *= wi; w2 *= wi;
            float mv[32]; float s = 0.f;
#pragma unroll
            for (int q = 0; q < 4; ++q) { const v4u a = pa[u][0][q], b = pa[u][1][q], c = pa[u][2][q];
                mv[8 * q + 0] = w0 * blo(a.x) + w1 * blo(b.x) + w2 * blo(c.x); mv[8 * q + 1] = w0 * bhi(a.x) + w1 * bhi(b.x) + w2 * bhi(c.x);
                mv[8 * q + 2] = w0 * blo(a.y) + w1 * blo(b.y) + w2 * blo(c.y); mv[8 * q + 3] = w0 * bhi(a.y) + w1 * bhi(b.y) + w2 * bhi(c.y);
                mv[8 * q + 4] = w0 * blo(a.z) + w1 * blo(b.z) + w2 * blo(c.z); mv[8 * q + 5] = w0 * bhi(a.z) + w1 * bhi(b.z) + w2 * bhi(c.z);
                mv[8 * q + 6] = w0 * blo(a.w) + w1 * blo(b.w) + w2 * blo(c.w); mv[8 * q + 7] = w0 * bhi(a.w) + w1 * bhi(b.w) + w2 * bhi(c.w); }
#pragma unroll
            for (int k = 0; k < 32; ++k) s += mv[k] * mv[k];
            const float r = 1.0f / sqrtf(wave_sum(s) * (1.f / ATTN_W) + EPS);
            GAS v4u* op = (GAS v4u*)(mixed + (size_t)t * D + 32 * lane);
#pragma unroll
            for (int q = 0; q < 4; ++q) { const f32x4 g0 = *(const GAS f32x4*)(gmix + 32 * lane + 8 * q), g1 = *(const GAS f32x4*)(gmix + 32 * lane + 8 * q + 4);
                v4u o; o.x = pk2(mv[8 * q] * r * g0.x, mv[8 * q + 1] * r * g0.y); o.y = pk2(mv[8 * q + 2] * r * g0.z, mv[8 * q + 3] * r * g0.w);
                o.z = pk2(mv[8 * q + 4] * r * g1.x, mv[8 * q + 5] * r * g1.y); o.w = pk2(mv[8 * q + 6] * r * g1.z, mv[8 * q + 7] * r * g1.w); op[q] = o; }
        }
        {   float s = 0.f;
#pragma unroll
            for (int q = 0; q < 2; ++q) { const v4u a = sa[u][q]; const float e0 = blo(a.x), e1 = bhi(a.x), e2 = blo(a.y), e3 = bhi(a.y), e4 = blo(a.z), e5 = bhi(a.z), e6 = blo(a.w), e7 = bhi(a.w);
                s += (e0 * e0 + e1 * e1) + (e2 * e2 + e3 * e3) + (e4 * e4 + e5 * e5) + (e6 * e6 + e7 * e7); }
            const float r = 1.0f / sqrtf(wave_sum(s) * (1.f / SSM_W) + EPS);
            GAS v4u* op = (GAS v4u*)(mixed + (size_t)t * D + 3072 + 16 * lane);
#pragma unroll
            for (int q = 0; q < 2; ++q) { const v4u a = sa[u][q]; const f32x4 g0 = *(const GAS f32x4*)(gmix + 3072 + 16 * lane + 8 * q), g1 = *(const GAS f32x4*)(gmix + 3072 + 16 * lane + 8 * q + 4);
                v4u o; o.x = pk2(blo(a.x) * r * g0.x, bhi(a.x) * r * g0.y); o.y = pk2(blo(a.y) * r * g0.z, bhi(a.y) * r * g0.w);
                o.z = pk2(blo(a.z) * r * g1.x, bhi(a.z) * r * g1.y); o.w = pk2(blo(a.w) * r * g1.z, bhi(a.w) * r * g1.w); op[q] = o; }
        }
    }
}

struct Args { const float* in[32]; float* out; unsigned char* ws; int ph_lo, ph_hi; };
constexpr int PT_OFF = LDSCTL_OFF + 1024;
__device__ __forceinline__ const float* pt_get(volatile LAS unsigned* PT, int i) {
    unsigned a = PT[2 * i], b = PT[2 * i + 1];
    a = __builtin_amdgcn_readfirstlane(a); b = __builtin_amdgcn_readfirstlane(b);
    return (const float*)(((unsigned long long)b << 32) | (unsigned long long)a);
}
__global__ void __launch_bounds__(NWAVES * 64, 2) fwd(Args args) {
    extern __shared__ __attribute__((aligned(16))) unsigned char lds_raw[];
    LAS unsigned char* lds = (LAS unsigned char*)lds_raw;
    volatile LAS unsigned* MISC = (volatile LAS unsigned*)(lds + MISC_OFF);
    volatile LAS unsigned* PT = (volatile LAS unsigned*)(lds + PT_OFF);
    const int tid0 = threadIdx.x, wave = __builtin_amdgcn_readfirstlane(tid0 >> 6);
    const int tid = tid0, lane = tid0 & 63;
    const int G0 = gridDim.x, bid0 = blockIdx.x;
    const int G = G0, bid = bid0, gw = bid * NWAVES + wave, NGW = G * NWAVES;
    for (int u = tid; u < 256; u += NWAVES * 64) ((LAS unsigned*)(lds + LDSCTL_OFF))[u] = 0u;
    if (tid == 0) {
#pragma unroll
        for (int i = 0; i < 32; ++i) { const unsigned long long v = (unsigned long long)args.in[i]; PT[2 * i] = (unsigned)v; PT[2 * i + 1] = (unsigned)(v >> 32); }
        { const unsigned long long v = (unsigned long long)args.out; PT[64] = (unsigned)v; PT[65] = (unsigned)(v >> 32); }
        { const unsigned long long v = (unsigned long long)args.ws; PT[66] = (unsigned)v; PT[67] = (unsigned)(v >> 32); }
    }
    __syncthreads();
    const int lo = args.ph_lo, hi = args.ph_hi;
    XcdBarrier bar; { unsigned char* ws0 = (unsigned char*)pt_get(PT, 33); bar.bar = (unsigned*)(ws0 + WS_CTL) + CW_BAR; bar.x = 0; bar.st = nullptr;
        if (hi - lo > 1) bar = xcd_barrier_post((unsigned*)(ws0 + WS_CTL) + CW_BAR, MISC + 8); }
#define IN(k) (lo <= (k) && (k) < hi)
#define SEAM(k) do { if (IN(k) && IN((k) + 1)) { XcdBarrier b_ = bar; unsigned long long p_ = (unsigned long long)b_.bar; unsigned x_ = b_.x; asm volatile("" : "+s"(p_), "+s"(x_)); b_.bar = (unsigned*)p_; b_.x = x_; xcd_barrier(b_); } } while (0)
#define PIN(i) pt_get(PT, (i))
#define WSP() ((unsigned char*)pt_get(PT, 33))
#define OUTP() ((float*)pt_get(PT, 32))
#if RES_PINGPONG
#define XBUF(ws, k) ({ int x_ = (3 * l + (k)) & 1; asm volatile("" : "+s"(x_)); (bf16*)((ws) + (x_ ? WS_XN2 : WS_XN)); })
#else
#define XBUF(ws, k) ((bf16*)((ws) + WS_XN))
#endif
#define PSB(ws, i) ((float*)((ws) + WS_PSX + (size_t)(i) * PSX_BYTES))
#define RSB(ws, i) ((float*)((ws) + WS_RSX + (size_t)(i) * RSX_BYTES))
#if REDUCE8
#define REDUCE_ROWS(ps_, rs_) reduce_rows8((ps_), (rs_), gw, NGW)
#else
#define REDUCE_ROWS(ps_, rs_) reduce_rows((ps_), (rs_), gw, NGW, lane)
#endif
#define REP(kind) for (int rep_ = 0; rep_ < 1 + ((PROBE_MASK >> (kind)) & 1); ++rep_)
#define DUMMY_F32(ws) ((float*)((ws) + WS_END3))
#define OPQ_LANE() int tid = tid0; asm volatile("" : "+v"(tid)); const int lane = tid & 63; (void)lane

    if (IN(0)) REP(0) {
        unsigned char* ws = WSP(); bf16* Wb = (bf16*)(ws + WS_W); bf16* MEMN = (bf16*)(ws + WS_MEMN);
        LAS unsigned char* scr = lds + RING_OFF + wave * 16384;
        int p0_ofs = 0;
#pragma unroll 1
        for (int mi = 0; mi < 8 * DEPTH; ++mi) {
            const int l = mi >> 3, k = mi & 7; const float* W; int K, N; size_t off;
            if (k == 0) { W = PIN(3); K = D; N = IN_W; off = OW_IN; } else if (k == 1) { W = PIN(21); K = D; N = D; off = OW_OUT; }
            else if (k == 2) { W = PIN(24); K = D; N = MEM_W; off = OW_CQ; } else if (k == 3) { W = PIN(25); K = D; N = 2 * MEM_W; off = OW_CKV; }
            else if (k == 4) { W = PIN(28); K = MEM_W; N = D; off = OW_CO; } else if (k == 5) { W = PIN(30); K = D; N = DFF; off = OW_UP; }
            else if (k == 6) { W = PIN(31); K = DFF; N = D; off = OW_DOWN; } else { W = PIN(18); K = SSM_W; N = SSM_W; off = OW_GLU; }
            W += (size_t)l * K * N; bf16* WT = Wb + (size_t)l * W_LAYER + off;
            const float* gk = (k == 0) ? PIN(2) + (size_t)l * D : (k == 2) ? PIN(22) + (size_t)l * D : (k == 5) ? PIN(29) + (size_t)l * D : nullptr;
            const int nit = (K / 64) * (N / 64);
#if P0_PAIR
            { const int nblk = N / 64;
              for (int q = gw; q < nit / 2; q += NGW) { const int kb2 = q / nblk, nb = q - kb2 * nblk, itA = 2 * kb2 * nblk + nb;
                  p0_transpose_pair(W, K, N, WT, scr, itA, itA + nblk, lane, k == 0, gk); } }
#else
            { int it0 = gw - p0_ofs; if (it0 < 0) it0 += NGW;
              for (int it = it0; it < nit; it += NGW) p0_transpose_tile(W, K, N, WT, scr, it, lane, k == 0, gk);
              p0_ofs = (p0_ofs + nit) % NGW; }
#endif
        }
#pragma unroll 1
        for (int l = 0; l < DEPTH; ++l) rmsnorm_rows(PIN(1), PIN(23) + (size_t)l * D, MEMN + (size_t)l * MM * D, MM, gw, NGW, lane);
    }
    SEAM(0);

#pragma unroll 1
    for (int l = 0; l < DEPTH; ++l) {
        const int pb = 1 + NPH_LAYER * l;
        const int lane = opq_lane_id(), tid = wave * 64 + lane;
        int G = G0, bid = bid0; asm volatile("" : "+s"(G), "+s"(bid)); const int gw = bid * NWAVES + wave, NGW = G * NWAVES;
        if (IN(pb + 0)) REP(1) { unsigned char* ws = WSP();
            if (l == 0) xb_rows(PIN(0), (bf16*)(ws + WS_XN), RSB(ws, 0), gw, NGW, lane);
            else REDUCE_ROWS(PSB(ws, 3 * l - 1), RSB(ws, 3 * l)); }
        SEAM(pb + 0);
        if (IN(pb + 1)) REP(2) { unsigned char* ws = WSP(); const bf16* Wl = (const bf16*)(ws + WS_W) + (size_t)l * W_LAYER;
            pg8::Gemm g{(const bf16*)XBUF(ws, 0), Wl + OW_IN, M, IN_W, D}; pg8::StaticOrder So; So.init(M, IN_W, G, bid);
            pg8::EpiInproj E{(bf16*)(ws + WS_R + R_QKVC), RSB(ws, 3 * l)};
            pg8::gemm_phase<pg8::EpiInproj, pg8::StaticOrder, PG8_ALIGN, PG8_SP2>(lds + RING_OFF, g, So, E, wave); }
        SEAM(pb + 1);
        if (IN(pb + 2)) {
            unsigned char* ws = WSP(); bf16* QKVC = (bf16*)(ws + WS_R + R_QKVC);
            REP(3) for (int u = bid; u < NB * SSM_G; u += G)
#if USE_SSM_MFMA == 2
                ssm_unit_hybrid(u, l, PIN(10), PIN(11), PIN(12), PIN(13), PIN(14), PIN(15), PIN(16) + (size_t)l * SSM_W, PIN(17), QKVC + (size_t)8 * M * 1024, (bf16*)(ws + WS_R + R_Z), lds + RING_OFF, tid, wave, lane);
#elif USE_SSM_MFMA
                ssm_unit_mfma(u, l, PIN(10), PIN(11), PIN(12), PIN(13), PIN(14), PIN(15), PIN(16) + (size_t)l * SSM_W, PIN(17), QKVC + (size_t)8 * M * 1024, (bf16*)(ws + WS_R + R_Z), lds + RING_OFF, wave, lane);
#else
                ssm_unit(u, l, PIN(10), PIN(11), PIN(12), PIN(13), PIN(14), PIN(15), PIN(16) + (size_t)l * SSM_W, PIN(17), QKVC + (size_t)8 * M * 1024, (bf16*)(ws + WS_R + R_Z), lds + RING_OFF, tid, wave, lane);
#endif
            { const float* gq = PIN(4) + l * HD; const float* gk = PIN(5) + l * HD; LAS float* G2 = (LAS float*)(lds + LDSCTL_OFF + 2048);
              { const int t_ = wave * 64 + opq_lane_id(); if (t_ < HD) G2[t_] = ((const GAS float*)gq)[t_] * ((const GAS float*)gk)[t_] * (QK_SCALE * LOG2E); }
              LDS_WAIT(); __syncthreads();
              bf16* PART = (bf16*)(ws + WS_R + R_ATT); float* LSE = (float*)(ws + WS_R + R_LSE);
              const brsrc_t rsQ = mk_rsrc(QKVC, 2u * M * 1024 * 2), rsK = mk_rsrc(QKVC + (size_t)2 * M * 1024, 2u * M * 1024 * 2), rsV = mk_rsrc(QKVC + (size_t)4 * M * 1024, 2u * M * 1024 * 2), rsO = mk_rsrc(PART, 3u * M * ATTN_W * 2);
              const bool xo = ATT_XCD_ORDER && G == 256; const int xcd = bid & 7, u = (bid >> 3) * NWAVES + wave;
              REP(4) {
#pragma unroll 1
                for (int s = 0; ; ++s) { int it;
                    if (xo) { if (s >= 12) break; const int dp = s / 3, li = u + 256 * (s - 3 * dp), hi2 = li >= 384 ? 1 : 0, rem = li - 384 * hi2, pr = xcd + 8 * (2 * dp + hi2); it = ((rem >> 7) << 13) | (pr << 7) | (rem & 127); }
                    else { it = gw + s * NGW; if (it >= 3 * NH * NB * 128) break; }
                    attn_mfma_item2<0>(it, rsQ, rsK, rsV, rsO, LSE, G2, lds + RING_OFF + wave * 17024, lane); } } }
            { const float* dw = PIN(6) + (size_t)l * CONV_K * CONV_W; const float* cb = PIN(7) + l * CONV_W; const float* lng = PIN(8) + l * CONV_W; const float* lnb = PIN(9) + l * CONV_W;
              const float* gmix = PIN(20) + (size_t)l * D; bf16* MIXED = (bf16*)(ws + WS_R + R_MIXED);
              LDS_WAIT(); __syncthreads();
              conv_stage_weights(dw, lds + RING_OFF, wave * 64 + opq_lane_id());
              LDS_WAIT(); __syncthreads();
              REP(5) for (int t4 = gw; t4 < M / 4; t4 += NGW)
                CONV_ITEM(4 * t4, QKVC + (size_t)6 * M * 1024, lds + RING_OFF, cb, lng, lnb, gmix, MIXED, lane); }
        }
        SEAM(pb + 2);
        if (IN(pb + 3)) REP(6) { unsigned char* ws = WSP(); const bf16* Wl = (const bf16*)(ws + WS_W) + (size_t)l * W_LAYER; bf16* ZB = (bf16*)(ws + WS_R + R_Z);
            pg8::Gemm g{ZB, Wl + OW_GLU, M, SSM_W, SSM_W}; pg8::StaticOrder So; So.init(M, SSM_W, G, bid);
            pg8::EpiGlu E{(bf16*)(ws + WS_R + R_SG), ZB, SSM_W, PIN(19) + l * SSM_W};
            pg8::gemm_phase<pg8::EpiGlu, pg8::StaticOrder, PG8_ALIGN, PG8_SP2>(lds + RING_OFF, g, So, E, wave); }
        SEAM(pb + 3);
        if (IN(pb + 4)) REP(7) { unsigned char* ws = WSP(); const float* gmix = PIN(20) + (size_t)l * D;
#if POST_PAIR
            { int t = gw;
              for (; t + NGW < M; t += 2 * NGW) post_item2(t, t + NGW, (const bf16*)(ws + WS_R + R_ATT), (const float*)(ws + WS_R + R_LSE), (const bf16*)(ws + WS_R + R_SG), gmix, (bf16*)(ws + WS_R + R_MIXED), lane);
              if (t < M) post_item(t, (const bf16*)(ws + WS_R + R_ATT), (const float*)(ws + WS_R + R_LSE), (const bf16*)(ws + WS_R + R_SG), gmix, (bf16*)(ws + WS_R + R_MIXED), lane); } }
#else
            for (int t = gw; t < M; t += NGW) post_item(t, (const bf16*)(ws + WS_R + R_ATT), (const float*)(ws + WS_R + R_LSE), (const bf16*)(ws + WS_R + R_SG), gmix, (bf16*)(ws + WS_R + R_MIXED), lane); }
#endif
        SEAM(pb + 4);
        if (IN(pb + 5)) REP(8) { unsigned char* ws = WSP(); const bf16* Wl = (const bf16*)(ws + WS_W) + (size_t)l * W_LAYER; float* out = OUTP(); const float* xin = (l == 0) ? PIN(0) : (const float*)out;
            pg8::Gemm g{(const bf16*)(ws + WS_R + R_MIXED), Wl + OW_OUT, M, D, D}; pg8::StaticOrder So; So.init(M, D, G, bid);
#if RES_BF16
            (void)xin; (void)out;
            pg8::EpiResB E{(const bf16*)XBUF(ws, 0), nullptr, D, XBUF(ws, 1), PSB(ws, 3 * l), M};
            pg8::gemm_phase<pg8::EpiResB, pg8::StaticOrder, PG8_ALIGN, PG8_SP2>(lds + RING_OFF, g, So, E, wave); }
#else
            pg8::EpiRes E{xin, rep_ ? DUMMY_F32(ws) : out, D, (bf16*)(ws + WS_XN), (float*)(ws + WS_R + R_PS), M};
            pg8::gemm_phase<pg8::EpiRes, pg8::StaticOrder, PG8_ALIGN, PG8_SP2>(lds + RING_OFF, g, So, E, wave); }
#endif
        SEAM(pb + 5);
        if (IN(pb + 6)) REP(1) { unsigned char* ws = WSP(); REDUCE_ROWS(PSB(ws, 3 * l), RSB(ws, 3 * l + 1)); }
        SEAM(pb + 6);
        if (IN(pb + 7)) REP(9) {
            unsigned char* ws = WSP(); const bf16* Wl = (const bf16*)(ws + WS_W) + (size_t)l * W_LAYER;
            const int ncq = (G >= 144) ? 128 : G, kv0 = (G >= 144) ? 128 : 0, nkv = (G >= 144) ? 16 : G;
            if (bid < ncq) { pg8::Gemm g{(const bf16*)XBUF(ws, 1), Wl + OW_CQ, M, MEM_W, D}; pg8::StaticOrder So; So.init(M, MEM_W, ncq, bid);
                pg8::EpiBf16<0> E{(bf16*)(ws + WS_QC), MEM_W, 0, 0, RSB(ws, 3 * l + 1)};
                pg8::gemm_phase<pg8::EpiBf16<0>, pg8::StaticOrder, PG8_ALIGN, PG8_SP2>(lds + RING_OFF, g, So, E, wave); }
            if (bid >= kv0 && bid < kv0 + nkv) { pg8::Gemm g{(const bf16*)(ws + WS_MEMN) + (size_t)l * MM * D, Wl + OW_CKV, MM, 2 * MEM_W, D}; pg8::StaticOrder So; So.init(MM, 2 * MEM_W, nkv, bid - kv0);
                pg8::EpiBf16<0> E{(bf16*)(ws + WS_KV) + (size_t)l * MM * 1024, 1024, 0, 0, nullptr};
                pg8::gemm_phase<pg8::EpiBf16<0>, pg8::StaticOrder, PG8_ALIGN, PG8_SP2>(lds + RING_OFF, g, So, E, wave); }
        }
        SEAM(pb + 7);
        if (IN(pb + 8)) REP(10) { unsigned char* ws = WSP(); LAS float* G2 = (LAS float*)(lds + LDSCTL_OFF + 2048);
            const bf16* KVl = (const bf16*)(ws + WS_KV) + (size_t)l * MM * 1024; const float* gq = PIN(26) + l * HD; const float* gk = PIN(27) + l * HD;
            { const int t_ = wave * 64 + opq_lane_id(); if (t_ < HD) G2[t_] = ((const GAS float*)gq)[t_] * ((const GAS float*)gk)[t_] * (QK_SCALE * LOG2E); }
            LDS_WAIT(); __syncthreads();
            const brsrc_t rsQ = mk_rsrc(ws + WS_QC, (unsigned)M * MEM_W * 2), rsK = mk_rsrc(KVl, (unsigned)MM * 1024 * 2), rsV = mk_rsrc(KVl + MEM_W, (unsigned)(MM * 1024 - MEM_W) * 2), rsO = mk_rsrc(ws + WS_OC, (unsigned)M * MEM_W * 2);
            for (int it = gw; it < NMH * (M / 32); it += NGW) attn_mfma_item2<1>(it, rsQ, rsK, rsV, rsO, nullptr, G2, lds + RING_OFF + wave * 17024, lane); }
        SEAM(pb + 8);
        if (IN(pb + 9)) REP(11) { unsigned char* ws = WSP(); const bf16* Wl = (const bf16*)(ws + WS_W) + (size_t)l * W_LAYER; float* out = OUTP();
            pg8::Gemm g{(const bf16*)(ws + WS_OC), Wl + OW_CO, M, D, MEM_W}; pg8::StaticOrder So; So.init(M, D, G, bid);
#if RES_BF16
            (void)out;
            pg8::EpiResB E{(const bf16*)XBUF(ws, 1), nullptr, D, XBUF(ws, 2), PSB(ws, 3 * l + 1), M};
            pg8::gemm_phase<pg8::EpiResB, pg8::StaticOrder, PG8_ALIGN, PG8_SP2>(lds + RING_OFF, g, So, E, wave); }
#else
            pg8::EpiRes E{out, rep_ ? DUMMY_F32(ws) : out, D, (bf16*)(ws + WS_XN), (float*)(ws + WS_R + R_PS), M};
            pg8::gemm_phase<pg8::EpiRes, pg8::StaticOrder, PG8_ALIGN, PG8_SP2>(lds + RING_OFF, g, So, E, wave); }
#endif
        SEAM(pb + 9);
        if (IN(pb + 10)) REP(1) { unsigned char* ws = WSP(); REDUCE_ROWS(PSB(ws, 3 * l + 1), RSB(ws, 3 * l + 2)); }
        SEAM(pb + 10);
        if (IN(pb + 11)) REP(12) { unsigned char* ws = WSP(); const bf16* Wl = (const bf16*)(ws + WS_W) + (size_t)l * W_LAYER;
            pg8::Gemm g{(const bf16*)XBUF(ws, 2), Wl + OW_UP, M, DFF, D}; pg8::StaticOrder So; So.init(M, DFF, G, bid);
            pg8::EpiBf16<3> E{(bf16*)(ws + WS_R + R_H), DFF, 0, 0, RSB(ws, 3 * l + 2)};
            pg8::gemm_phase<pg8::EpiBf16<3>, pg8::StaticOrder, PG8_ALIGN, PG8_SP2>(lds + RING_OFF, g, So, E, wave);
            }
        SEAM(pb + 11);
        if (IN(pb + 12)) REP(13) { unsigned char* ws = WSP(); const bf16* Wl = (const bf16*)(ws + WS_W) + (size_t)l * W_LAYER; float* out = OUTP();
            pg8::Gemm g{(const bf16*)(ws + WS_R + R_H), Wl + OW_DOWN, M, D, DFF}; pg8::StaticOrder So; So.init(M, D, G, bid);
#if RES_BF16
            pg8::EpiResB E{(const bf16*)XBUF(ws, 2), (l + 1 < DEPTH) ? nullptr : out, D, (l + 1 < DEPTH) ? XBUF(ws, 3) : nullptr, PSB(ws, 3 * l + 2), M};
            pg8::gemm_phase<pg8::EpiResB, pg8::StaticOrder, PG8_ALIGN, PG8_SP2>(lds + RING_OFF, g, So, E, wave); }
#else
            pg8::EpiRes E{out, rep_ ? DUMMY_F32(ws) : out, D, (l + 1 < DEPTH) ? (bf16*)(ws + WS_XN) : nullptr, (float*)(ws + WS_R + R_PS), M};
            pg8::gemm_phase<pg8::EpiRes, pg8::StaticOrder, PG8_ALIGN, PG8_SP2>(lds + RING_OFF, g, So, E, wave); }
#endif
        SEAM(pb + 12);
    }
#undef IN
#undef SEAM
}

extern "C" void kernel_launch(void* const* d_in, const int* in_sizes, int n_in, void* d_out, int out_size, void* d_ws, size_t ws_size, hipStream_t stream) {
    static int grid = 0;
    if (grid == 0) {
        if (n_in != 32 || in_sizes[0] != M * D || out_size != M * D || ws_size < WS_END3 + (PROBE_MASK ? (size_t)M * D * 4 : 0)) { fprintf(stderr, "kernel_launch: unexpected shapes (n_in %d, in0 %d, out %d, ws %zu < %zu); nothing launched\n", n_in, n_in > 0 ? in_sizes[0] : -1, out_size, ws_size, (size_t)WS_END); grid = -1; return; }
        int dev = 0, cus = 0, per_cu = 0;
        if (hipGetDevice(&dev) != hipSuccess || hipDeviceGetAttribute(&cus, hipDeviceAttributeMultiprocessorCount, dev) != hipSuccess) { fprintf(stderr, "kernel_launch: device query failed\n"); grid = -1; return; }
        if (hipFuncSetAttribute((const void*)fwd, hipFuncAttributeMaxDynamicSharedMemorySize, LDS_BYTES) != hipSuccess) { fprintf(stderr, "kernel_launch: hipFuncSetAttribute failed\n"); grid = -1; return; }
        if (hipOccupancyMaxActiveBlocksPerMultiprocessor(&per_cu, (const void*)fwd, NWAVES * 64, LDS_BYTES) != hipSuccess || per_cu < 1)
            fprintf(stderr, "kernel_launch: note: occupancy query reports %d workgroups per CU\n", per_cu);
        (void)hipGetLastError();
        grid = cus;
    }
    if (grid < 0) return;
    if (hipMemsetAsync((char*)d_ws + WS_CTL, 0, CTL_ZERO_BYTES, stream) != hipSuccess) { fprintf(stderr, "kernel_launch: memset failed\n"); return; }
#if PROBE_ZERO_WS
    (void)hipMemsetAsync((char*)d_ws + CTL_ZERO_BYTES, 0, WS_END - CTL_ZERO_BYTES, stream); (void)hipMemsetAsync(d_out, 0, (size_t)M * D * 4, stream);
#endif
    Args a{};
    for (int i = 0; i < 32; ++i) a.in[i] = (const float*)d_in[i];
    a.out = (float*)d_out; a.ws = (unsigned char*)d_ws;
#if MK_ONE_LAUNCH
    a.ph_lo = 0; a.ph_hi = NPH;
    hipLaunchKernelGGL(fwd, dim3(grid), dim3(NWAVES * 64), LDS_BYTES, stream, a);
#else
    for (int p = 0; p < NPH; ++p) { a.ph_lo = p; a.ph_hi = p + 1; hipLaunchKernelGGL(fwd, dim3(grid), dim3(NWAVES * 64), LDS_BYTES, stream, a); }
#endif
    const hipError_t le = hipPeekAtLastError();
    if (le != hipSuccess) fprintf(stderr, "kernel_launch: launch failed: %s\n", hipGetErrorName(le));
}
```
